# Optimizing an MI355X kernel written in HIP

```python
import jax, jax.numpy as jnp
from jax import lax
import numpy as np

D_MODEL = 1024
BATCH = 4
SEQ = 4096
DEPTH = 2

GRID_W = 64
CTX_LEN = 256
N_HEADS = 8
QK_NOPE = 128
QK_ROPE = 64
V_DIM = 128
Q_LORA = 256
KV_LORA = 128
POOL_W = 512
POOL_WINDOWS = (2, 4, 8, 16)
N_POOL_GROUPS = 4
POOL_GROUP = POOL_W // N_POOL_GROUPS
D_FF = -(-8 * D_MODEL // (3 * 256)) * 256
N_BRANCH = 2
N_MOD = 6
ROPE_THETA = 10000.0
ROPE_AXIS = QK_ROPE // 2
EPS = 1e-6
Q_BLOCK = 128
ATTN_SCALE = (QK_NOPE + QK_ROPE) ** -0.5

OFF_KV = Q_LORA
OFF_KR = OFF_KV + KV_LORA
OFF_POOL = OFF_KR + QK_ROPE
OFF_GATE = OFF_POOL + POOL_W
D_IN = OFF_GATE + N_BRANCH * D_MODEL

kernel_name = 'hybrid_mla_pool_dit_block'


def rms_norm(x, g):
    x32 = x.astype(jnp.float32)
    y = x32 * lax.rsqrt(jnp.mean(x32 * x32, axis=-1, keepdims=True) + EPS)
    return (y * g.astype(jnp.float32)).astype(x.dtype)


def modulate(h, shift, scale):
    return h * (1.0 + scale) + shift


def axial_angles(n_tokens):
    rows = n_tokens // GRID_W
    row = jnp.repeat(jnp.arange(rows), GRID_W)
    col = jnp.tile(jnp.arange(GRID_W), rows)
    pos = jnp.stack([row, col], axis=-1).astype(jnp.float32)
    inv_freq = ROPE_THETA ** (-jnp.arange(0, ROPE_AXIS, 2, dtype=jnp.float32) / ROPE_AXIS)
    return pos[:, :, None] * inv_freq


def apply_rope_2d(x, ang):
    shp = x.shape
    xr = x.astype(jnp.float32).reshape(shp[:-1] + (2, 2, QK_ROPE // 4))
    x1, x2 = xr[..., 0, :], xr[..., 1, :]
    cos, sin = jnp.cos(ang), jnp.sin(ang)
    out = jnp.stack([x1 * cos - x2 * sin, x1 * sin + x2 * cos], axis=-2)
    return out.reshape(shp).astype(x.dtype)


def mla_queries(z_q, q_norm, w_uq):
    q = rms_norm(z_q, q_norm) @ w_uq
    q = q.reshape(q.shape[:-1] + (N_HEADS, QK_NOPE + QK_ROPE))
    return q[..., :QK_NOPE], q[..., QK_NOPE:]


def mla_keys_values(z_kv, kv_norm, w_ukv):
    kv = rms_norm(z_kv, kv_norm) @ w_ukv
    kv = kv.reshape(kv.shape[:-1] + (N_HEADS, QK_NOPE + V_DIM))
    return kv[..., :QK_NOPE], kv[..., QK_NOPE:]


def attend(q_nope, q_rope, k_nope, k_rope, v):
    s = jnp.einsum('bqhd,bkhd->bhqk', q_nope, k_nope) + jnp.einsum('bqhr,bkr->bhqk', q_rope, k_rope)
    p = jax.nn.softmax(s.astype(jnp.float32) * ATTN_SCALE, axis=-1).astype(v.dtype)
    return jnp.einsum('bhqk,bkhd->bqhd', p, v)


def attend_blocked(q_nope, q_rope, k_nope, k_rope, v):
    b, t = q_nope.shape[:2]
    nb = t // Q_BLOCK
    qn = q_nope.reshape(b, nb, Q_BLOCK, N_HEADS, QK_NOPE).swapaxes(0, 1)
    qr = q_rope.reshape(b, nb, Q_BLOCK, N_HEADS, QK_ROPE).swapaxes(0, 1)
    o = lax.map(lambda qs: attend(qs[0], qs[1], k_nope, k_rope, v), (qn, qr))
    return o.swapaxes(0, 1).reshape(b, t, N_HEADS, V_DIM)


def multiscale_pool(u, w_pool, pool_scale, w_o_pool):
    b, t = u.shape[:2]
    cs = jnp.pad(jnp.cumsum(u.astype(jnp.float32), axis=1), ((0, 0), (1, 0), (0, 0)))
    pos = jnp.arange(t)
    groups = []
    for g, w in enumerate(POOL_WINDOWS):
        lo = jnp.clip(pos - w // 2, 0, t)
        hi = jnp.clip(pos + (w - w // 2), 0, t)
        sl = slice(g * POOL_GROUP, (g + 1) * POOL_GROUP)
        csg = cs[:, :, sl]
        mean = (csg[:, hi] - csg[:, lo]) / (hi - lo).astype(jnp.float32)[None, :, None]
        groups.append(mean.astype(u.dtype) - u[:, :, sl])
    d = jnp.stack(groups, axis=2)
    y = jnp.einsum('btgc,gce->btge', d, w_pool).reshape(b, t, POOL_W) * pool_scale
    return y @ w_o_pool


def mix_branches(z, o_att, w_o_mla, w_pool, pool_scale, w_o_pool, w_out):
    b, t = z.shape[:2]
    o_pool = multiscale_pool(z[..., OFF_POOL:OFF_GATE], w_pool, pool_scale, w_o_pool)
    gates = jax.nn.sigmoid(z[..., OFF_GATE:]).reshape(b, t, N_BRANCH, D_MODEL)
    merged = gates[:, :, 0] * (o_att.reshape(b, t, N_HEADS * V_DIM) @ w_o_mla) + gates[:, :, 1] * o_pool
    return merged @ w_out


def swiglu(h, w_gate, w_up, w_down):
    return (jax.nn.silu(h @ w_gate) * (h @ w_up)) @ w_down


def setup_inputs(seed: int = 0) -> dict:
    key = jax.random.key(seed)
    ks = jax.random.split(key, 24)
    f32 = jnp.float32

    def nrm(k, shape, fan_in):
        return jax.random.normal(k, shape, f32) * fan_in ** -0.5

    def gain(k, shape):
        return 1.0 + 0.05 * jax.random.normal(k, shape, f32)

    return {
        'x': jax.random.normal(ks[0], (BATCH, SEQ, D_MODEL), f32),
        'c': jax.random.normal(ks[1], (BATCH, D_MODEL), f32),
        'ctx': jax.random.normal(ks[2], (BATCH, CTX_LEN, D_MODEL), f32),
        'c_ctx': jax.random.normal(ks[3], (D_MODEL,), f32),
        'w_ada': nrm(ks[4], (DEPTH, D_MODEL, N_MOD * D_MODEL), D_MODEL),
        'b_ada': 0.01 * jax.random.normal(ks[5], (DEPTH, N_MOD * D_MODEL), f32),
        'g_pre_mix': gain(ks[6], (DEPTH, D_MODEL)),
        'w_in': nrm(ks[7], (DEPTH, D_MODEL, D_IN), D_MODEL),
        'q_norm': gain(ks[8], (DEPTH, Q_LORA)),
        'w_uq': nrm(ks[9], (DEPTH, Q_LORA, N_HEADS * (QK_NOPE + QK_ROPE)), Q_LORA),
        'kv_norm': gain(ks[10], (DEPTH, KV_LORA)),
        'w_ukv': nrm(ks[11], (DEPTH, KV_LORA, N_HEADS * (QK_NOPE + V_DIM)), KV_LORA),
        'w_o_mla': nrm(ks[12], (DEPTH, N_HEADS * V_DIM, D_MODEL), N_HEADS * V_DIM),
        'w_pool': nrm(ks[13], (DEPTH, N_POOL_GROUPS, POOL_GROUP, POOL_GROUP), POOL_GROUP),
        'pool_scale': 1.0 + 0.1 * jax.random.normal(ks[14], (DEPTH, POOL_W), f32),
        'w_o_pool': nrm(ks[15], (DEPTH, POOL_W, D_MODEL), POOL_W),
        'w_out': nrm(ks[16], (DEPTH, D_MODEL, D_MODEL), D_MODEL),
        'g_post_mix': gain(ks[17], (DEPTH, D_MODEL)),
        'g_pre_ffn': gain(ks[18], (DEPTH, D_MODEL)),
        'w_ffn_gate': nrm(ks[19], (DEPTH, D_MODEL, D_FF), D_MODEL),
        'w_ffn_up': nrm(ks[20], (DEPTH, D_MODEL, D_FF), D_MODEL),
        'w_ffn_down': nrm(ks[21], (DEPTH, D_FF, D_MODEL), D_FF),
        'g_post_ffn': gain(ks[22], (DEPTH, D_MODEL)),
    }


def reference(x, c, ctx, c_ctx, w_ada, b_ada, g_pre_mix, w_in, q_norm, w_uq, kv_norm, w_ukv, w_o_mla,
              w_pool, pool_scale, w_o_pool, w_out, g_post_mix, g_pre_ffn, w_ffn_gate, w_ffn_up, w_ffn_down,
              g_post_ffn):
    b, t, _ = x.shape
    ang = axial_angles(t).astype(x.dtype)
    xc = ctx
    for l in range(DEPTH):
        last = l == DEPTH - 1
        mod_x = (jax.nn.silu(c) @ w_ada[l] + b_ada[l]).reshape(b, 1, N_MOD, D_MODEL)
        mod_c = (jax.nn.silu(c_ctx) @ w_ada[l] + b_ada[l]).reshape(1, 1, N_MOD, D_MODEL)

        h = modulate(rms_norm(x, g_pre_mix[l]), mod_x[:, :, 1], mod_x[:, :, 0])
        hc = modulate(rms_norm(xc, g_pre_mix[l]), mod_c[:, :, 1], mod_c[:, :, 0])
        z = h @ w_in[l]
        if last:
            zc_kv = hc @ w_in[l][:, OFF_KV:OFF_POOL]
        else:
            zc = hc @ w_in[l]
            zc_kv = zc[..., OFF_KV:OFF_POOL]
        kc_nope, vc = mla_keys_values(zc_kv[..., :KV_LORA], kv_norm[l], w_ukv[l])
        kc_rope = zc_kv[..., KV_LORA:]
        q_nope, q_rope = mla_queries(z[..., :OFF_KV], q_norm[l], w_uq[l])
        q_rope = apply_rope_2d(q_rope, ang[:, None])
        k_nope, v = mla_keys_values(z[..., OFF_KV:OFF_KR], kv_norm[l], w_ukv[l])
        k_rope = apply_rope_2d(z[..., OFF_KR:OFF_POOL], ang)
        o = attend_blocked(q_nope, q_rope,
                           jnp.concatenate([kc_nope, k_nope], axis=1),
                           jnp.concatenate([kc_rope, k_rope], axis=1),
                           jnp.concatenate([vc, v], axis=1))
        y = mix_branches(z, o, w_o_mla[l], w_pool[l], pool_scale[l], w_o_pool[l], w_out[l])
        x = x + mod_x[:, :, 2] * rms_norm(y, g_post_mix[l])
        if not last:
            qc_nope, qc_rope = mla_queries(zc[..., :OFF_KV], q_norm[l], w_uq[l])
            oc = attend(qc_nope, qc_rope, kc_nope, kc_rope, vc)
            yc = mix_branches(zc, oc, w_o_mla[l], w_pool[l], pool_scale[l], w_o_pool[l], w_out[l])
            xc = xc + mod_c[:, :, 2] * rms_norm(yc, g_post_mix[l])

        hf = modulate(rms_norm(x, g_pre_ffn[l]), mod_x[:, :, 4], mod_x[:, :, 3])
        x = x + mod_x[:, :, 5] * rms_norm(swiglu(hf, w_ffn_gate[l], w_ffn_up[l], w_ffn_down[l]), g_post_ffn[l])
        if not last:
            hfc = modulate(rms_norm(xc, g_pre_ffn[l]), mod_c[:, :, 4], mod_c[:, :, 3])
            xc = xc + mod_c[:, :, 5] * rms_norm(swiglu(hfc, w_ffn_gate[l], w_ffn_up[l], w_ffn_down[l]), g_post_ffn[l])
    return x
```

```cpp
#include <hip/hip_runtime.h>
#include <cstdio>
#include <cstdint>

constexpr int DM = 1024, NB = 4, SEQ = 4096, DEPTH = 2, CTX = 256, NH = 8, NOPE = 128, ROPE = 64, VD = 128;
constexpr int QL = 256, KVL = 128, PW = 512, DFF = 2816, DIN = 3008, NMOD = 6;
constexpr int OFF_KV = 256, OFF_KR = 384, OFF_POOL = 448, OFF_GATE = 960;
constexpr int MB = CTX + SEQ;
constexpr float EPS = 1e-6f;
constexpr float ATTN_SCALE = 0.07216878364870322f;

__device__ __forceinline__ float block_sum256(float v, float* red) {
    for (int o = 32; o > 0; o >>= 1) v += __shfl_xor(v, o);
    const int w = threadIdx.x >> 6;
    __syncthreads();
    if ((threadIdx.x & 63) == 0) red[w] = v;
    __syncthreads();
    return red[0] + red[1] + red[2] + red[3];
}

__global__ void __launch_bounds__(256) k_mod(const float* __restrict__ c, const float* __restrict__ cctx, const float* __restrict__ w_ada,
                                             const float* __restrict__ b_ada, float* __restrict__ MOD) {
    __shared__ float sv[5][DM];
    const int l = blockIdx.y, n = blockIdx.x * 256 + threadIdx.x;
    for (int i = threadIdx.x; i < 5 * DM; i += 256) { const int s = i / DM, k = i % DM; const float v = s < 4 ? c[s * DM + k] : cctx[k]; sv[s][k] = v / (1.f + __expf(-v)); }
    __syncthreads();
    float a0 = 0, a1 = 0, a2 = 0, a3 = 0, a4 = 0;
    const float* W = w_ada + (size_t)l * DM * (NMOD * DM) + n;
    for (int k = 0; k < DM; ++k) { const float w = W[(size_t)k * (NMOD * DM)]; a0 += sv[0][k] * w; a1 += sv[1][k] * w; a2 += sv[2][k] * w; a3 += sv[3][k] * w; a4 += sv[4][k] * w; }
    const float bb = b_ada[l * NMOD * DM + n];
    float* M = MOD + (size_t)l * 5 * NMOD * DM + n;
    M[0 * NMOD * DM] = a0 + bb; M[1 * NMOD * DM] = a1 + bb; M[2 * NMOD * DM] = a2 + bb; M[3 * NMOD * DM] = a3 + bb; M[4 * NMOD * DM] = a4 + bb;
}

__global__ void __launch_bounds__(256) k_load_x(const float* __restrict__ x, const float* __restrict__ ctx, float* __restrict__ XS, int b) {
    const int r = blockIdx.x;
    const float* src = r < CTX ? ctx + ((size_t)b * CTX + r) * DM : x + ((size_t)b * SEQ + (r - CTX)) * DM;
    for (int i = threadIdx.x; i < DM; i += 256) XS[(size_t)r * DM + i] = src[i];
}
__global__ void __launch_bounds__(256) k_store_x(const float* __restrict__ XS, float* __restrict__ out, int b) {
    const int r = blockIdx.x;
    for (int i = threadIdx.x; i < DM; i += 256) out[((size_t)b * SEQ + r) * DM + i] = XS[(size_t)(CTX + r) * DM + i];
}

__global__ void __launch_bounds__(256) k_rmsmod(const float* __restrict__ X, const float* __restrict__ g, const float* __restrict__ modL, const float* __restrict__ modC,
                                                int ksc, int ksh, float* __restrict__ H) {
    __shared__ float red[4];
    const int r = blockIdx.x; const float* xr = X + (size_t)r * DM; const float* mod = r < CTX ? modC : modL;
    float v[4], ss = 0;
    for (int j = 0; j < 4; ++j) { v[j] = xr[threadIdx.x + 256 * j]; ss += v[j] * v[j]; }
    ss = block_sum256(ss, red);
    const float rstd = rsqrtf(ss / DM + EPS);
    for (int j = 0; j < 4; ++j) { const int cidx = threadIdx.x + 256 * j; H[(size_t)r * DM + cidx] = v[j] * rstd * g[cidx] * (1.f + mod[ksc * DM + cidx]) + mod[ksh * DM + cidx]; }
}
__global__ void __launch_bounds__(256) k_resid(float* __restrict__ X, const float* __restrict__ Y, const float* __restrict__ g, const float* __restrict__ modL, const float* __restrict__ modC, int kg) {
    __shared__ float red[4];
    const int r = blockIdx.x; const float* yr = Y + (size_t)r * DM; const float* mod = r < CTX ? modC : modL;
    float v[4], ss = 0;
    for (int j = 0; j < 4; ++j) { v[j] = yr[threadIdx.x + 256 * j]; ss += v[j] * v[j]; }
    ss = block_sum256(ss, red);
    const float rstd = rsqrtf(ss / DM + EPS);
    for (int j = 0; j < 4; ++j) { const int cidx = threadIdx.x + 256 * j; X[(size_t)r * DM + cidx] += mod[kg * DM + cidx] * (v[j] * rstd * g[cidx]); }
}

__global__ void __launch_bounds__(256) k_gemm(const float* __restrict__ A, int lda, const float* __restrict__ W, int ldw, float* __restrict__ C, int ldc, int K) {
    __shared__ float As[16][68], Ws[16][68];
    const int tx = threadIdx.x & 15, ty = threadIdx.x >> 4, m0 = blockIdx.y * 64, n0 = blockIdx.x * 64;
    float acc[4][4] = {};
    for (int k0 = 0; k0 < K; k0 += 16) {
        for (int i = threadIdx.x; i < 64 * 16; i += 256) { const int m = i >> 4, k = i & 15; As[k][m] = A[(size_t)(m0 + m) * lda + k0 + k]; }
        for (int i = threadIdx.x; i < 64 * 16; i += 256) { const int k = i >> 6, n = i & 63; Ws[k][n] = W[(size_t)(k0 + k) * ldw + n0 + n]; }
        __syncthreads();
#pragma unroll
        for (int k = 0; k < 16; ++k) {
            float a[4], w[4];
#pragma unroll
            for (int i = 0; i < 4; ++i) { a[i] = As[k][ty * 4 + i]; w[i] = Ws[k][tx * 4 + i]; }
#pragma unroll
            for (int i = 0; i < 4; ++i)
#pragma unroll
                for (int j = 0; j < 4; ++j) acc[i][j] += a[i] * w[j];
        }
        __syncthreads();
    }
    for (int i = 0; i < 4; ++i) for (int j = 0; j < 4; ++j) C[(size_t)(m0 + ty * 4 + i) * ldc + n0 + tx * 4 + j] = acc[i][j];
}

__global__ void __launch_bounds__(256) k_qkvprep(const float* __restrict__ Z, const float* __restrict__ qn, const float* __restrict__ kvn, float* __restrict__ AQ, float* __restrict__ AKV) {
    __shared__ float red[4];
    const int r = blockIdx.x, t = threadIdx.x; const float* z = Z + (size_t)r * DIN;
    const float vq = z[t]; const float sq = block_sum256(vq * vq, red);
    const float vk = t < KVL ? z[OFF_KV + t] : 0.f; const float sk = block_sum256(vk * vk, red);
    AQ[(size_t)r * QL + t] = vq * rsqrtf(sq / QL + EPS) * qn[t];
    if (t < KVL) AKV[(size_t)r * KVL + t] = vk * rsqrtf(sk / KVL + EPS) * kvn[t];
}
__global__ void __launch_bounds__(256) k_rope(float* __restrict__ Q, const float* __restrict__ Z, float* __restrict__ KR) {
    const int r = blockIdx.x, t = threadIdx.x;
    for (int p = t; p < 9 * 32; p += 256) {
        const int vec = p / 32, pi = p % 32, axis = pi / 16, f = pi % 16;
        float x1, x2;
        if (vec < 8) { x1 = Q[(size_t)r * 1536 + vec * 192 + 128 + axis * 32 + f]; x2 = Q[(size_t)r * 1536 + vec * 192 + 128 + axis * 32 + 16 + f]; }
        else { x1 = Z[(size_t)r * DIN + OFF_KR + axis * 32 + f]; x2 = Z[(size_t)r * DIN + OFF_KR + axis * 32 + 16 + f]; }
        float o1 = x1, o2 = x2;
        if (r >= CTX) {
            const int tpos = r - CTX; const float pos = axis == 0 ? (float)(tpos / 64) : (float)(tpos % 64);
            const float inv = powf(10000.f, -(float)(2 * f) / 32.f); const float ang = pos * inv;
            const float cs = cosf(ang), sn = sinf(ang);
            o1 = x1 * cs - x2 * sn; o2 = x1 * sn + x2 * cs;
        }
        if (vec < 8) { Q[(size_t)r * 1536 + vec * 192 + 128 + axis * 32 + f] = o1; Q[(size_t)r * 1536 + vec * 192 + 128 + axis * 32 + 16 + f] = o2; }
        else { KR[(size_t)r * ROPE + axis * 32 + f] = o1; KR[(size_t)r * ROPE + axis * 32 + 16 + f] = o2; }
    }
}

constexpr int AT_LDS = (64 * 193 + 32 * 193 + 32 * 128 + 64 * 33) * 4;
__global__ void __launch_bounds__(256) k_attn(const float* __restrict__ Q, const float* __restrict__ KV, const float* __restrict__ KR, float* __restrict__ O) {
    extern __shared__ __attribute__((aligned(16))) float sm[];
    float* Qs = sm; float* Ks = Qs + 64 * 193; float* Vs = Ks + 32 * 193; float* Ps = Vs + 32 * 128;
    const int t = threadIdx.x, qi = t >> 2, part = t & 3, h = blockIdx.y, q0 = blockIdx.x * 64;
    const int nkeys = q0 < CTX ? CTX : MB;
    for (int i = t; i < 64 * 192; i += 256) { const int rr = i / 192, k = i % 192; Qs[rr * 193 + k] = Q[(size_t)(q0 + rr) * 1536 + h * 192 + k] * ATTN_SCALE; }
    float m = -1e30f, l = 0.f, acc[32];
    for (int d = 0; d < 32; ++d) acc[d] = 0.f;
    for (int j0 = 0; j0 < nkeys; j0 += 32) {
        __syncthreads();
        for (int i = t; i < 32 * 192; i += 256) { const int j = i / 192, k = i % 192; Ks[j * 193 + k] = k < 128 ? KV[(size_t)(j0 + j) * 2048 + h * 256 + k] : KR[(size_t)(j0 + j) * ROPE + (k - 128)]; }
        for (int i = t; i < 32 * 128; i += 256) { const int j = i / 128, d = i % 128; Vs[j * 128 + d] = KV[(size_t)(j0 + j) * 2048 + h * 256 + 128 + d]; }
        __syncthreads();
        float s[8];
        for (int jj = 0; jj < 8; ++jj) s[jj] = 0.f;
        for (int k = 0; k < 192; ++k) { const float qv = Qs[qi * 193 + k];
#pragma unroll
            for (int jj = 0; jj < 8; ++jj) s[jj] += qv * Ks[(part * 8 + jj) * 193 + k]; }
        float mx = s[0];
        for (int jj = 1; jj < 8; ++jj) mx = fmaxf(mx, s[jj]);
        mx = fmaxf(mx, __shfl_xor(mx, 1)); mx = fmaxf(mx, __shfl_xor(mx, 2));
        const float mn = fmaxf(m, mx), alpha = __expf(m - mn); m = mn;
        float ps = 0.f;
        for (int jj = 0; jj < 8; ++jj) { const float p = __expf(s[jj] - mn); ps += p; Ps[qi * 33 + part * 8 + jj] = p; }
        ps += __shfl_xor(ps, 1); ps += __shfl_xor(ps, 2);
        l = l * alpha + ps;
        __syncthreads();
        for (int d = 0; d < 32; ++d) acc[d] *= alpha;
        for (int j = 0; j < 32; ++j) { const float p = Ps[qi * 33 + j];
#pragma unroll
            for (int d = 0; d < 32; ++d) acc[d] += p * Vs[j * 128 + d * 4 + part]; }
    }
    const float rl = 1.f / l;
    for (int d = 0; d < 32; ++d) O[(size_t)(q0 + qi) * DM + h * 128 + d * 4 + part] = acc[d] * rl;
}

__global__ void __launch_bounds__(256) k_pool(const float* __restrict__ Z, float* __restrict__ D) {
    const int r = blockIdx.x;
    const int base = r < CTX ? 0 : CTX, T = r < CTX ? CTX : SEQ, pos = r - base;
    for (int c = threadIdx.x; c < PW; c += 256) {
        const int g = c / 128, w = 2 << g;
        int lo = pos - w / 2; if (lo < 0) lo = 0; int hi = pos + (w - w / 2); if (hi > T) hi = T;
        float s = 0.f;
        for (int i = lo; i < hi; ++i) s += Z[(size_t)(base + i) * DIN + OFF_POOL + c];
        D[(size_t)r * PW + c] = s / (float)(hi - lo) - Z[(size_t)r * DIN + OFF_POOL + c];
    }
}
__global__ void __launch_bounds__(256) k_pscale(float* __restrict__ Y1, const float* __restrict__ ps) {
    const int r = blockIdx.x;
    for (int c = threadIdx.x; c < PW; c += 256) Y1[(size_t)r * PW + c] *= ps[c];
}
__global__ void __launch_bounds__(256) k_merge(const float* __restrict__ Z, const float* OA, const float* __restrict__ OP, float* MG) {
    const int r = blockIdx.x;
    for (int c = threadIdx.x; c < DM; c += 256) {
        const float g0 = 1.f / (1.f + __expf(-Z[(size_t)r * DIN + OFF_GATE + c])), g1 = 1.f / (1.f + __expf(-Z[(size_t)r * DIN + OFF_GATE + DM + c]));
        MG[(size_t)r * DM + c] = g0 * OA[(size_t)r * DM + c] + g1 * OP[(size_t)r * DM + c];
    }
}
__global__ void __launch_bounds__(256) k_swiglu(const float* __restrict__ G, const float* __restrict__ U, float* __restrict__ ACT) {
    const int r = blockIdx.x;
    for (int c = threadIdx.x; c < DFF; c += 256) { const float g = G[(size_t)r * DFF + c]; ACT[(size_t)r * DFF + c] = g / (1.f + __expf(-g)) * U[(size_t)r * DFF + c]; }
}

static void gemm(hipStream_t st, const float* A, int lda, const float* W, int ldw, float* C, int ldc, int M, int N, int K) {
    hipLaunchKernelGGL(k_gemm, dim3(N / 64, M / 64), dim3(256), 0, st, A, lda, W, ldw, C, ldc, K);
}

extern "C" void kernel_launch(void* const* d_in, const int* in_sizes, int n_in, void* d_out, int out_size, void* d_ws, size_t ws_size, hipStream_t stream) {
    const float* x = (const float*)d_in[0]; const float* c = (const float*)d_in[1]; const float* ctx = (const float*)d_in[2]; const float* cctx = (const float*)d_in[3];
    const float* w_ada = (const float*)d_in[4]; const float* b_ada = (const float*)d_in[5]; const float* g_pre_mix = (const float*)d_in[6]; const float* w_in = (const float*)d_in[7];
    const float* q_norm = (const float*)d_in[8]; const float* w_uq = (const float*)d_in[9]; const float* kv_norm = (const float*)d_in[10]; const float* w_ukv = (const float*)d_in[11];
    const float* w_o_mla = (const float*)d_in[12]; const float* w_pool = (const float*)d_in[13]; const float* pool_scale = (const float*)d_in[14]; const float* w_o_pool = (const float*)d_in[15];
    const float* w_out = (const float*)d_in[16]; const float* g_post_mix = (const float*)d_in[17]; const float* g_pre_ffn = (const float*)d_in[18]; const float* w_gate = (const float*)d_in[19];
    const float* w_up = (const float*)d_in[20]; const float* w_down = (const float*)d_in[21]; const float* g_post_ffn = (const float*)d_in[22];
    float* out = (float*)d_out;
    static int once = 0;
    if (!once) { once = 1; hipFuncSetAttribute((const void*)k_attn, hipFuncAttributeMaxDynamicSharedMemorySize, AT_LDS);
        fprintf(stderr, "kernel_launch: ws_size = %zu bytes\n", ws_size); }
    float* p = (float*)d_ws;
    auto take = [&](size_t n) { float* r = p; p += (n + 63) / 64 * 64; return r; };
    float* MOD = take((size_t)DEPTH * 5 * NMOD * DM);
    float* XS = take((size_t)MB * DM);
    float* H = take((size_t)MB * DM);
    float* Z = take((size_t)MB * DIN);
    float* ZX = take((size_t)MB * (2 * DFF - DIN));
    (void)ZX;
    float* AQ = take((size_t)MB * QL);
    float* AKV = take((size_t)MB * KVL);
    float* Qb = take((size_t)MB * 1536);
    float* KVb = take((size_t)MB * 2048);
    float* KR = take((size_t)MB * ROPE);
    float* Ob = take((size_t)MB * DM);
    float* Db = take((size_t)MB * PW);
    float* Y1 = take((size_t)MB * PW);
    float* OA = take((size_t)MB * DM);
    float* OP = H;
    float* MG = OA;
    float* Y = Ob;
    float* ACT = Qb;
    if ((size_t)((char*)p - (char*)d_ws) > ws_size) { fprintf(stderr, "kernel_launch: workspace too small\n"); return; }

    hipLaunchKernelGGL(k_mod, dim3(NMOD * DM / 256, DEPTH), dim3(256), 0, stream, c, cctx, w_ada, b_ada, MOD);
    for (int b = 0; b < NB; ++b) {
        hipLaunchKernelGGL(k_load_x, dim3(MB), dim3(256), 0, stream, x, ctx, XS, b);
        for (int l = 0; l < DEPTH; ++l) {
            const float* modL = MOD + ((size_t)l * 5 + b) * NMOD * DM; const float* modC = MOD + ((size_t)l * 5 + 4) * NMOD * DM;
            hipLaunchKernelGGL(k_rmsmod, dim3(MB), dim3(256), 0, stream, XS, g_pre_mix + l * DM, modL, modC, 0, 1, H);
            gemm(stream, H, DM, w_in + (size_t)l * DM * DIN, DIN, Z, DIN, MB, DIN, DM);
            hipLaunchKernelGGL(k_qkvprep, dim3(MB), dim3(256), 0, stream, Z, q_norm + l * QL, kv_norm + l * KVL, AQ, AKV);
            gemm(stream, AQ, QL, w_uq + (size_t)l * QL * 1536, 1536, Qb, 1536, MB, 1536, QL);
            gemm(stream, AKV, KVL, w_ukv + (size_t)l * KVL * 2048, 2048, KVb, 2048, MB, 2048, KVL);
            hipLaunchKernelGGL(k_rope, dim3(MB), dim3(256), 0, stream, Qb, Z, KR);
            hipLaunchKernelGGL(k_attn, dim3(MB / 64, NH), dim3(256), AT_LDS, stream, Qb, KVb, KR, Ob);
            hipLaunchKernelGGL(k_pool, dim3(MB), dim3(256), 0, stream, Z, Db);
            for (int g = 0; g < 4; ++g) gemm(stream, Db + g * 128, PW, w_pool + ((size_t)l * 4 + g) * 128 * 128, 128, Y1 + g * 128, PW, MB, 128, 128);
            hipLaunchKernelGGL(k_pscale, dim3(MB), dim3(256), 0, stream, Y1, pool_scale + l * PW);
            gemm(stream, Y1, PW, w_o_pool + (size_t)l * PW * DM, DM, OP, DM, MB, DM, PW);
            gemm(stream, Ob, DM, w_o_mla + (size_t)l * DM * DM, DM, OA, DM, MB, DM, DM);
            hipLaunchKernelGGL(k_merge, dim3(MB), dim3(256), 0, stream, Z, OA, OP, MG);
            gemm(stream, MG, DM, w_out + (size_t)l * DM * DM, DM, Y, DM, MB, DM, DM);
            hipLaunchKernelGGL(k_resid, dim3(MB), dim3(256), 0, stream, XS, Y, g_post_mix + l * DM, modL, modC, 2);
            hipLaunchKernelGGL(k_rmsmod, dim3(MB), dim3(256), 0, stream, XS, g_pre_ffn + l * DM, modL, modC, 3, 4, H);
            float* Gb = Z; float* Ub = Z + (size_t)MB * DFF;
            gemm(stream, H, DM, w_gate + (size_t)l * DM * DFF, DFF, Gb, DFF, MB, DFF, DM);
            gemm(stream, H, DM, w_up + (size_t)l * DM * DFF, DFF, Ub, DFF, MB, DFF, DM);
            hipLaunchKernelGGL(k_swiglu, dim3(MB), dim3(256), 0, stream, Gb, Ub, ACT);
            gemm(stream, ACT, DFF, w_down + (size_t)l * DFF * DM, DM, Y, DM, MB, DM, DFF);
            hipLaunchKernelGGL(k_resid, dim3(MB), dim3(256), 0, stream, XS, Y, g_post_ffn + l * DM, modL, modC, 5);
        }
        hipLaunchKernelGGL(k_store_x, dim3(SEQ), dim3(256), 0, stream, XS, out, b);
    }
}
```

```cpp
#include <hip/hip_runtime.h>
#include <hip/hip_cooperative_groups.h>
#include <cstdio>
#include <cstdint>
namespace cg = cooperative_groups;

#ifndef USE_MFMA_GEMM
#define USE_MFMA_GEMM 1
#endif
#ifndef GEMM_MASK
#define GEMM_MASK 0xff
#endif
#define GEMM_ON(k) ((GEMM_MASK >> (k)) & 1)
#ifndef PROBE_DUP
#define PROBE_DUP 0
#endif
#define DUP(k) ((PROBE_DUP >> (k)) & 1)
#ifndef ATTN_ABL
#define ATTN_ABL 0
#endif
#ifndef GEMM_ALIGN
#define GEMM_ALIGN true
#endif
#ifndef GEMM_SP2
#define GEMM_SP2 true
#endif
#ifndef USE_ATTN2
#define USE_ATTN2 1
#endif
#ifndef NATIVE_PV
#define NATIVE_PV 1
#endif
#ifndef ATTN2_DMA
#define ATTN2_DMA 1
#endif
#ifndef ATTN2_MSEG
#define ATTN2_MSEG 1
#endif
#ifndef XS_BF16
#define XS_BF16 1
#endif
#ifndef SM_NEGM
#define SM_NEGM 1
#endif
#ifndef ATTN2_PM
#define ATTN2_PM 0
#endif
#ifndef ATTN2_PV
#define ATTN2_PV 0
#endif
#ifndef ATTN2_GSEL
#define ATTN2_GSEL 0
#endif
#ifndef USE_CG_FIRST
#define USE_CG_FIRST 2
#endif
#ifndef USE_MFMA_ATTN
#define USE_MFMA_ATTN 1
#endif

constexpr int DM = 1024, NB = 4, SEQ = 4096, DEPTH = 2, CTX = 256, NH = 8;
constexpr int QL = 256, KVL = 128, ROPE = 64, PW = 512, DFF = 2816, DIN = 3008, NMOD = 6;
constexpr int OFF_KV = 256, OFF_KR = 384, OFF_POOL = 448, OFF_GATE = 960;
constexpr int NCTX = NB * CTX;
constexpr int MROWS = NCTX + NB * SEQ;
constexpr int ZAW = 960, QW = NH * 192, KW = 192, NIN = 3072, NGU = 2 * DFF;
constexpr int KPB = CTX + SEQ;
constexpr float EPS = 1e-6f;
constexpr float C2 = 0.07216878364870322f * 1.4426950408889634f;
constexpr int NTHREADS = 512, NWAVES = 8;
constexpr int LZY0 = (MROWS / 256) * (DM / 256) - 256;
constexpr int LDS_BYTES = 147456;

typedef unsigned short bf16_t;
typedef short bf16x8 __attribute__((ext_vector_type(8)));
typedef float f32x4 __attribute__((ext_vector_type(4)));
typedef float f32x2 __attribute__((ext_vector_type(2)));
typedef float f32x16 __attribute__((ext_vector_type(16)));
typedef unsigned u32x4 __attribute__((ext_vector_type(4)));
typedef unsigned u32x2 __attribute__((ext_vector_type(2)));

constexpr size_t MiB = 1u << 20;
constexpr size_t WS_CTL = 0;
constexpr size_t WS_MOD = 1 * MiB;
constexpr size_t WS_TAB = WS_MOD + 256 * 1024;
constexpr size_t WS_RSTDQ = WS_TAB + 16 * 1024;
constexpr size_t WS_XC = 2 * MiB;
constexpr size_t WS_W = 6 * MiB;
constexpr size_t W_IN = 0, W_Q = W_IN + (size_t)NIN * DM, W_O = W_Q + (size_t)QW * QL, W_PC = W_O + (size_t)DM * DM, W_OUT = W_PC + (size_t)DM * PW,
                 W_GU = W_OUT + (size_t)DM * DM, W_DN = W_GU + (size_t)NGU * DM, W_END = W_DN + (size_t)DM * DFF;
constexpr size_t LW_BYTES = W_END * 2;
constexpr size_t WS_AR = WS_W + 2 * LW_BYTES + (MiB - (2 * LW_BYTES) % MiB) % MiB;
constexpr size_t AR_G0 = WS_AR, AR_Y = AR_G0, AR_F = AR_G0;
constexpr size_t AR_G1 = WS_AR + 34 * MiB, AR_HF = AR_G1;
constexpr size_t AR_Q = WS_AR + 68 * MiB, AR_H = AR_Q, AR_MG = AR_Q, AR_ACT = AR_Q;
constexpr size_t AR_ZA = WS_AR + 119 * MiB, AR_O = AR_ZA;
constexpr size_t AR_D = WS_AR + 151 * MiB;
constexpr size_t AR_KL = WS_AR + 168 * MiB;
constexpr size_t WS_SLZ = WS_AR + 175 * MiB;
constexpr size_t AR_SLD = AR_G1;
constexpr int NSD = DFF / 256;
constexpr size_t WS_END = WS_SLZ + 4 * MiB;
static_assert(WS_END <= 256 * MiB, "workspace map exceeds 256 MiB");
static_assert((size_t)MROWS * ZAW * 2 <= 32 * MiB && (size_t)MROWS * DFF * 2 <= 100 * MiB - 6 * MiB, "arena");

__device__ __forceinline__ unsigned cvt_pk_bf16(float lo, float hi) { unsigned r; asm volatile("v_cvt_pk_bf16_f32 %0, %1, %2" : "=v"(r) : "v"(lo), "v"(hi)); return r; }
__device__ __forceinline__ float bf2f(unsigned short u) { return __uint_as_float((unsigned)u << 16); }
__device__ __forceinline__ float bflo(unsigned u) { return __uint_as_float(u << 16); }
__device__ __forceinline__ float bfhi(unsigned u) { return __uint_as_float(u & 0xffff0000u); }
__device__ __forceinline__ float wave_sum(float v) {
#pragma unroll
    for (int o = 1; o < 64; o <<= 1) v += __shfl_xor(v, o);
    return v;
}
__device__ __forceinline__ float sigmoidf_(float x) { return __builtin_amdgcn_rcpf(1.f + __builtin_amdgcn_exp2f(x * -1.4426950408889634f)); }

#ifndef USE_WT_STORES
#define USE_WT_STORES 1
#endif
__device__ __forceinline__ void st16(void* p, u32x4 v) {
#if USE_WT_STORES
    asm volatile("global_store_dwordx4 %0, %1, off sc1\n\ts_nop 1" :: "v"((__attribute__((address_space(1))) void*)p), "v"(v) : "memory");
#else
    *(u32x4*)p = v;
#endif
}
struct Args { const float* in[23]; float* out; unsigned char* ws; int ph_lo, ph_hi; };
typedef const __attribute__((address_space(4))) Args* KArgs;
__device__ __forceinline__ KArgs kargs() { KArgs p = (KArgs)__builtin_amdgcn_kernarg_segment_ptr(); asm volatile("" : "+s"(p)); return p; }
typedef __attribute__((address_space(1))) unsigned char* gws_t;
typedef __attribute__((address_space(1))) float* gout_t;
struct Ctx {
    gout_t out; gws_t ws;
    int tid, lane, wave, G, bid;
    __device__ __forceinline__ const float* in(int i) const { return kargs()->in[i]; }
};
__device__ __forceinline__ float* xs_row(const Ctx& C, int r) { return r < NCTX ? (float*)(C.ws + WS_XC) + (size_t)r * DM : (float*)(C.out + (size_t)(r - NCTX) * DM); }
__device__ __forceinline__ const float* xin_row(const Ctx& C, int r) { return r < NCTX ? C.in(2) + (size_t)r * DM : C.in(0) + (size_t)(r - NCTX) * DM; }
__device__ __forceinline__ int mod_slot(int r) { return r < NCTX ? 4 : (r - NCTX) / SEQ; }
__device__ __forceinline__ int key_index(int r) { return r < NCTX ? (r / CTX) * KPB + (r % CTX) : ((r - NCTX) / SEQ) * KPB + CTX + (r - NCTX) % SEQ; }

constexpr int BM = 256, NXCD = 8, WGM = 8;
struct Unit { int pm, pn, koff, ks; };
template <int LDA, int LDB, int KK> struct Gemm { const bf16_t* A; const bf16_t* Bt; static constexpr int lda = LDA, ldb = LDB, K = KK; };
struct StaticOrder {
    int nM, nN, nwg, G, c, pm0;
    __device__ void init(int nM_, int nN_, int G_, int c_, int pm0_ = 0) { nM = nM_; nN = nN_; nwg = nM * nN; G = G_; c = c_; pm0 = pm0_; }
    __device__ bool next(int i, Unit& u) const {
        const long L = (long)i * G + c; if (L >= nwg) return false;
        int wgid = (int)L; { const int q = nwg / NXCD, r = nwg % NXCD, xcd = wgid % NXCD, off = wgid / NXCD; wgid = (xcd < r ? xcd * (q + 1) : r * (q + 1) + (xcd - r) * q) + off; }
        const int nig = WGM * nN, gid = wgid / nig, fm = gid * WGM, gsz = (nM - fm) < WGM ? (nM - fm) : WGM;
        u.pm = pm0 + fm + ((wgid % nig) % gsz); u.pn = (wgid % nig) / gsz; u.koff = 0; u.ks = 0; return true;
    }
    __device__ __forceinline__ void a_ready(const Unit&) const {}
    __device__ __forceinline__ void done(const Unit&) const {}
};

struct SplitOrder {
    int nN, NS, KS, nwg, G, c, pm0, pn0;
    __device__ void init(int nM_, int nN_, int NS_, int KS_, int G_, int c_, int pm0_, int pn0_) { nN = nN_; NS = NS_; KS = KS_; nwg = nM_ * nN_ * NS_; G = G_; c = c_; pm0 = pm0_; pn0 = pn0_; }
    __device__ bool next(int i, Unit& u) const {
        const int L = i * G + c; if (L >= nwg) return false;
        const int ks = L % NS, t = L / NS; u.pn = pn0 + t % nN; u.pm = pm0 + t / nN; u.koff = ks * KS; u.ks = ks; return true;
    }
    __device__ __forceinline__ void a_ready(const Unit&) const {}
    __device__ __forceinline__ void done(const Unit&) const {}
};

#define EPI_LOOP_ROWS for (int ai = AI_LO; ai < AI_HI; ++ai) _Pragma("unroll") for (int m = 0; m < 4; ++m)

struct EpiZ {
    static constexpr bool PERM = true, AFTER_DRAIN = false;
    bf16_t* ZA; bf16_t* G0; bf16_t* G1;
    template <int AI_LO = 0, int AI_HI = 2> __device__ __forceinline__ void run(const f32x4 (&acc)[2][2][4][2], const Unit& u, int wr, int wc, int fr, int fq) const {
#pragma unroll
        EPI_LOOP_ROWS { const int row = u.pm * BM + ai * 128 + wr * 64 + m * 16 + fr;
#pragma unroll
            for (int bj = 0; bj < 2; ++bj) { const int c0 = u.pn * BM + bj * 128 + wc * 32 + 8 * fq; f32x4 v0 = acc[ai][bj][m][0], v1 = acc[ai][bj][m][1];
                bf16_t* dst;
                if (c0 < ZAW) dst = ZA + (size_t)row * ZAW + c0;
                else if (c0 < DIN) { const bool g1 = c0 >= OFF_GATE + DM; dst = (g1 ? G1 + (c0 - OFF_GATE - DM) : G0 + (c0 - OFF_GATE)) + (size_t)row * DM;
#pragma unroll
                    for (int i = 0; i < 4; ++i) { v0[i] = sigmoidf_(v0[i]); v1[i] = sigmoidf_(v1[i]); } }
                else continue;
                u32x4 w; w.x = cvt_pk_bf16(v0[0], v0[1]); w.y = cvt_pk_bf16(v0[2], v0[3]); w.z = cvt_pk_bf16(v1[0], v1[1]); w.w = cvt_pk_bf16(v1[2], v1[3]);
                st16(dst, w); }
            __builtin_amdgcn_sched_barrier(0); }
    }
};
template <int MODE, int LDC = DM> struct EpiN {
    static constexpr bool PERM = true, AFTER_DRAIN = false;
    bf16_t* O; const bf16_t* G; const bf16_t* T;
    template <int AI_LO = 0, int AI_HI = 2> __device__ __forceinline__ void run(const f32x4 (&acc)[2][2][4][2], const Unit& u, int wr, int wc, int fr, int fq) const {
        constexpr int NIT = (AI_HI - AI_LO) * 4;
        const int row0 = u.pm * BM + wr * 64 + fr, colb = u.pn * BM + wc * 32 + 8 * fq;
        u32x4 gb[2][2], tb[2][2];
        auto ld = [&](int it, int buf) { const int ai = AI_LO + it / 4, m = it % 4; const size_t off = (size_t)(row0 + ai * 128 + m * 16) * LDC + colb;
            if (MODE == 1) { gb[buf][0] = __builtin_nontemporal_load((const u32x4*)(O + off)); gb[buf][1] = __builtin_nontemporal_load((const u32x4*)(O + off + 128)); }
            if (MODE == 2) { gb[buf][0] = __builtin_nontemporal_load((const u32x4*)(G + off)); gb[buf][1] = __builtin_nontemporal_load((const u32x4*)(G + off + 128)); tb[buf][0] = __builtin_nontemporal_load((const u32x4*)(T + off)); tb[buf][1] = __builtin_nontemporal_load((const u32x4*)(T + off + 128)); } };
        if (MODE != 0) ld(0, 0);
#pragma unroll
        for (int it = 0; it < NIT; ++it) { const int ai = AI_LO + it / 4, m = it % 4, buf = it & 1;
            if (MODE != 0 && it + 1 < NIT) ld(it + 1, buf ^ 1);
#pragma unroll
            for (int bj = 0; bj < 2; ++bj) { const size_t off = (size_t)(row0 + ai * 128 + m * 16) * LDC + colb + bj * 128;
                f32x4 v0 = acc[ai][bj][m][0], v1 = acc[ai][bj][m][1];
                if (MODE == 1) { const u32x4 g = gb[buf][bj];
                    v0[0] *= bflo(g.x); v0[1] *= bfhi(g.x); v0[2] *= bflo(g.y); v0[3] *= bfhi(g.y); v1[0] *= bflo(g.z); v1[1] *= bfhi(g.z); v1[2] *= bflo(g.w); v1[3] *= bfhi(g.w); }
                if (MODE == 2) { const u32x4 g = gb[buf][bj]; const u32x4 t = tb[buf][bj];
                    v0[0] = v0[0] * bflo(g.x) + bflo(t.x); v0[1] = v0[1] * bfhi(g.x) + bfhi(t.x); v0[2] = v0[2] * bflo(g.y) + bflo(t.y); v0[3] = v0[3] * bfhi(g.y) + bfhi(t.y);
                    v1[0] = v1[0] * bflo(g.z) + bflo(t.z); v1[1] = v1[1] * bfhi(g.z) + bfhi(t.z); v1[2] = v1[2] * bflo(g.w) + bflo(t.w); v1[3] = v1[3] * bfhi(g.w) + bfhi(t.w); }
                u32x4 w; w.x = cvt_pk_bf16(v0[0], v0[1]); w.y = cvt_pk_bf16(v0[2], v0[3]); w.z = cvt_pk_bf16(v1[0], v1[1]); w.w = cvt_pk_bf16(v1[2], v1[3]);
                st16(O + off, w); }
            __builtin_amdgcn_sched_barrier(0); }
    }
};
template <int LD, int ROWS, bool F32> struct EpiSlab {
    static constexpr bool PERM = true, AFTER_DRAIN = false;
    void* SL; int col0;
    template <int AI_LO = 0, int AI_HI = 2> __device__ __forceinline__ void run(const f32x4 (&acc)[2][2][4][2], const Unit& u, int wr, int wc, int fr, int fq) const {
#pragma unroll
        EPI_LOOP_ROWS { const int row = u.pm * BM + ai * 128 + wr * 64 + m * 16 + fr;
#pragma unroll
            for (int bj = 0; bj < 2; ++bj) { const int c0 = u.pn * BM + bj * 128 + wc * 32 + 8 * fq - col0; const size_t off = ((size_t)u.ks * ROWS + row) * LD + c0;
                const f32x4 v0 = acc[ai][bj][m][0], v1 = acc[ai][bj][m][1];
                if (F32) { *(f32x4*)((float*)SL + off) = v0; *(f32x4*)((float*)SL + off + 4) = v1; }
                else { u32x4 w; w.x = cvt_pk_bf16(v0[0], v0[1]); w.y = cvt_pk_bf16(v0[2], v0[3]); w.z = cvt_pk_bf16(v1[0], v1[1]); w.w = cvt_pk_bf16(v1[2], v1[3]); st16((bf16_t*)SL + off, w); } } }
    }
};
struct EpiGU {
    static constexpr bool PERM = true, AFTER_DRAIN = false;
    bf16_t* ACT;
    template <int AI_LO = 0, int AI_HI = 2> __device__ __forceinline__ void run(const f32x4 (&acc)[2][2][4][2], const Unit& u, int wr, int wc, int fr, int fq) const {
#pragma unroll
        EPI_LOOP_ROWS { const int row = u.pm * BM + ai * 128 + wr * 64 + m * 16 + fr; const int c0 = u.pn * 128 + wc * 32 + 8 * fq;
            f32x4 g0 = acc[ai][0][m][0], g1 = acc[ai][0][m][1]; const f32x4 u0 = acc[ai][1][m][0], u1 = acc[ai][1][m][1];
#pragma unroll
            for (int i = 0; i < 4; ++i) { g0[i] = g0[i] * sigmoidf_(g0[i]) * u0[i]; g1[i] = g1[i] * sigmoidf_(g1[i]) * u1[i]; }
            u32x4 w; w.x = cvt_pk_bf16(g0[0], g0[1]); w.y = cvt_pk_bf16(g0[2], g0[3]); w.z = cvt_pk_bf16(g1[0], g1[1]); w.w = cvt_pk_bf16(g1[2], g1[3]);
            st16(ACT + (size_t)row * DFF + c0, w);
            __builtin_amdgcn_sched_barrier(0); }
    }
};

template <int AI, class Epi, class GemmT>
__device__ __forceinline__ void gemm_simple_half(const GemmT& g, const Unit& u, const Epi& E, int wr, int wc, int fr, int fq) {
    f32x4 acc[2][2][4][2];
#pragma unroll
    for (int b = 0; b < 2; ++b)
#pragma unroll
        for (int m = 0; m < 4; ++m)
#pragma unroll
            for (int n = 0; n < 2; ++n) acc[AI][b][m][n] = (f32x4){0.f, 0.f, 0.f, 0.f};
    const bf16_t* Ab = g.A + (size_t)(u.pm * BM + AI * 128 + wr * 64 + fr) * g.lda + u.koff;
    const bf16_t* Bb = g.Bt + (size_t)(u.pn * BM + wc * 32 + 8 * fq) * g.ldb + u.koff;
    for (int k0 = 0; k0 < g.K; k0 += 4) {
        float af[4][4];
#pragma unroll
        for (int m = 0; m < 4; ++m) { const u32x2 a = *(const u32x2*)(Ab + (size_t)(m * 16) * g.lda + k0);
            af[m][0] = bflo(a.x); af[m][1] = bfhi(a.x); af[m][2] = bflo(a.y); af[m][3] = bfhi(a.y); }
#pragma unroll
        for (int bj = 0; bj < 2; ++bj)
#pragma unroll
            for (int n = 0; n < 2; ++n)
#pragma unroll
                for (int i = 0; i < 4; ++i) { const u32x2 b = *(const u32x2*)(Bb + (size_t)(bj * 128 + 4 * n + i) * g.ldb + k0);
                    float bf[4]; bf[0] = bflo(b.x); bf[1] = bfhi(b.x); bf[2] = bflo(b.y); bf[3] = bfhi(b.y);
#pragma unroll
                    for (int m = 0; m < 4; ++m) { float sacc = acc[AI][bj][m][n][i];
#pragma unroll
                        for (int k = 0; k < 4; ++k) sacc += af[m][k] * bf[k];
                        acc[AI][bj][m][n][i] = sacc; } }
    }
    E.template run<AI, AI + 1>(acc, u, wr, wc, fr, fq);
}
template <class Epi, class Sched, class GemmT>
__device__ __forceinline__ void gemm_simple(const GemmT g, const Sched& S, const Epi& E) {
    const int tid = threadIdx.x, wid = tid >> 6, lane = tid & 63, wr = wid >> 2, wc = wid & 3, fr = lane & 15, fq = lane >> 4;
    Unit u;
    for (int it = 0; S.next(it, u); ++it) { gemm_simple_half<0, Epi, GemmT>(g, u, E, wr, wc, fr, fq); gemm_simple_half<1, Epi, GemmT>(g, u, E, wr, wc, fr, fq); }
}

#define PG8_LAS __attribute__((address_space(3)))
constexpr int BK = 64, HALF = 128, HTB = HALF * BK * 2  , STAGE_BYTES = 8 * HTB;
__host__ __device__ __forceinline__ int lds_byte(int r, int c) { const int st = (r >> 4) * 2 + (c >> 5), rr = r & 15, cc = c & 31, ob = rr * 64 + cc * 2; return st * 1024 + (ob ^ (((ob >> 9) & 1) << 5)); }
__host__ __device__ __forceinline__ void stage_rc(int b, int& R, int& C) { const int st = b / 1024, sb = b % 1024, swz = sb ^ (((sb >> 9) & 1) << 5); R = (st >> 1) * 16 + swz / 64; C = (st & 1) * 32 + (swz % 64) / 2; }
__host__ __device__ __forceinline__ int perm32(int rho) { const int n = rho >> 4, i = rho & 15; return 8 * (i >> 2) + 4 * n + (i & 3); }
template <class Epi, class Sched, bool ALIGN_EPI, bool SP2, class GemmT>
__device__ __forceinline__ void gemm_phase(PG8_LAS unsigned char* lds, const GemmT g, const Sched& S, const Epi& E) {
    int tid_l = threadIdx.x; asm volatile("" : "+v"(tid_l));
    const int tid = tid_l, wid = __builtin_amdgcn_readfirstlane(tid >> 6), lane = tid & 63, wr = wid >> 2, wc = wid & 3, fr = lane & 15, fq = lane >> 4;
    constexpr int K = GemmT::K, nt = K / BK; constexpr int lda = GemmT::lda, ldb = GemmT::ldb;
    unsigned voffA[2], voffB[2];
#pragma unroll
    for (int i = 0; i < 2; ++i) { int R, C; stage_rc(tid * 16 + i * 8192, R, C); const int Rb = Epi::PERM ? ((R & ~31) + perm32(R & 31)) : R;
        voffA[i] = (unsigned)(R * lda + C) * 2u; voffB[i] = (unsigned)(Rb * ldb + C) * 2u; }
    const size_t kstep = (size_t)(BK * 2);
    const size_t hstepA = (size_t)HALF * lda * 2, hstepB = (size_t)HALF * ldb * 2;
    const size_t tstepA = 2 * hstepA, tstepB = 2 * hstepB;
    const unsigned ldsw = (unsigned)wid * 1024u;
    const int aoff = lds_byte(wr * 64 + fr, fq * 8), boff = lds_byte(wc * 32 + fr, fq * 8);
#define PG8_SA(b, h) (((b) * 2 + (h)) * HTB)
#define PG8_SB(b, h) ((4 + (b) * 2 + (h)) * HTB)
#define PG8_STAGE(bufoff, gbase, voff) do { _Pragma("unroll") for (int _i = 0; _i < 2; ++_i) { unsigned _o = (voff)[_i]; asm volatile("" : "+v"(_o)); \
        __builtin_amdgcn_global_load_lds((const unsigned*)((const char*)(gbase) + _o), (PG8_LAS unsigned*)(lds + (bufoff) + ldsw + _i * 8192), 16, 0, 0); } } while (0)
#define PG8_LDA(dst, b, h) do { _Pragma("unroll") for (int m = 0; m < 4; ++m) _Pragma("unroll") for (int k = 0; k < 2; ++k) dst[m][k] = *(const PG8_LAS bf16x8*)(lds + PG8_SA(b, h) + aoff + m * 2048 + k * 1024); } while (0)
#define PG8_LDB(dst, b, h) do { _Pragma("unroll") for (int n = 0; n < 2; ++n) _Pragma("unroll") for (int k = 0; k < 2; ++k) dst[n][k] = *(const PG8_LAS bf16x8*)(lds + PG8_SB(b, h) + boff + n * 2048 + k * 1024); } while (0)
#define PG8_MMA(ai, bj, At, Bt) do { __builtin_amdgcn_s_setprio(1); _Pragma("unroll") for (int m = 0; m < 4; ++m) _Pragma("unroll") for (int n = 0; n < 2; ++n) _Pragma("unroll") for (int k = 0; k < 2; ++k) \
        acc[ai][bj][m][n] = __builtin_amdgcn_mfma_f32_16x16x32_bf16(Bt[n][k], At[m][k], acc[ai][bj][m][n], 0, 0, 0); __builtin_amdgcn_s_setprio(0); } while (0)
#define PG8_WAIT_V(n) asm volatile("s_waitcnt vmcnt(" #n ")" ::: "memory")
#define PG8_WAIT_L(n) asm volatile("s_waitcnt lgkmcnt(" #n ")" ::: "memory")
#define PG8_BAR __builtin_amdgcn_s_barrier()
#define PG8_SCHED __builtin_amdgcn_sched_barrier(0)
    Unit cur, nxt; int ui = 0;
    if (!S.next(0, cur)) return;
    f32x4 acc[2][2][4][2];
#pragma unroll
    for (int a = 0; a < 2; ++a)
#pragma unroll
        for (int b = 0; b < 2; ++b)
#pragma unroll
            for (int m = 0; m < 4; ++m)
#pragma unroll
                for (int n = 0; n < 2; ++n) acc[a][b][m][n] = (f32x4){0.f, 0.f, 0.f, 0.f};
    bf16x8 At[4][2], B0[2][2], B1[2][2];
    const char* cA = (const char*)g.A + (size_t)cur.pm * tstepA + (size_t)cur.koff * 2; const char* cB = (const char*)g.Bt + (size_t)cur.pn * tstepB + (size_t)cur.koff * 2;
    S.a_ready(cur);
    if constexpr (SP2) {
        PG8_STAGE(PG8_SB(0, 0), cB, voffB); PG8_STAGE(PG8_SB(0, 1), cB + hstepB, voffB); PG8_STAGE(PG8_SA(0, 0), cA, voffA); PG8_STAGE(PG8_SA(0, 1), cA + hstepA, voffA);
        if (wr == 1) PG8_BAR;
        PG8_WAIT_V(2); PG8_BAR;
        PG8_STAGE(PG8_SB(1, 0), cB + kstep, voffB); PG8_STAGE(PG8_SA(1, 0), cA + kstep, voffA); PG8_STAGE(PG8_SB(1, 1), cB + hstepB + kstep, voffB);
        PG8_WAIT_V(6); PG8_BAR;
    } else {
        PG8_STAGE(PG8_SB(0, 0), cB, voffB); PG8_STAGE(PG8_SA(0, 0), cA, voffA); PG8_STAGE(PG8_SB(0, 1), cB + hstepB, voffB); PG8_STAGE(PG8_SA(0, 1), cA + hstepA, voffA);
        if (wr == 1) PG8_BAR;
        PG8_WAIT_V(4); PG8_BAR;
        PG8_STAGE(PG8_SB(1, 0), cB + kstep, voffB); PG8_STAGE(PG8_SA(1, 0), cA + kstep, voffA); PG8_STAGE(PG8_SB(1, 1), cB + hstepB + kstep, voffB);
        PG8_WAIT_V(6); PG8_BAR;
    }
    for (;;) {
        const bool has_next = S.next(ui + 1, nxt);
        const char* nA = has_next ? (const char*)g.A + (size_t)nxt.pm * tstepA + (size_t)nxt.koff * 2 : cA; const char* nB = has_next ? (const char*)g.Bt + (size_t)nxt.pn * tstepB + (size_t)nxt.koff * 2 : cB;
#pragma nounroll
        for (int t = 0; t < nt; t += 2) {
            const bool last = (t == nt - 2);
            const char* a1 = cA + (size_t)(t + 1) * kstep;
            const char* a2 = last ? nA : cA + (size_t)(t + 2) * kstep; const char* b2 = last ? nB : cB + (size_t)(t + 2) * kstep;
            const char* a3 = a2 + kstep; const char* b3 = b2 + kstep;
            if (last && has_next) S.a_ready(nxt);
            if constexpr (SP2) {
            PG8_LDB(B0, 0, 0); PG8_LDB(B1, 0, 1); PG8_SCHED; PG8_LDA(At, 0, 0); PG8_STAGE(PG8_SA(1, 1), a1 + hstepA, voffA);
            PG8_WAIT_V(8); PG8_WAIT_L(0); PG8_BAR; PG8_MMA(0, 0, At, B0); PG8_MMA(0, 1, At, B1); PG8_BAR; PG8_SCHED;
            PG8_LDA(At, 0, 1); PG8_STAGE(PG8_SB(0, 0), b2, voffB); PG8_STAGE(PG8_SB(0, 1), b2 + hstepB, voffB); PG8_STAGE(PG8_SA(0, 0), a2, voffA);
            PG8_WAIT_V(8); PG8_WAIT_L(0); PG8_BAR; PG8_MMA(1, 0, At, B0); PG8_MMA(1, 1, At, B1); PG8_BAR; PG8_SCHED;
            PG8_LDB(B0, 1, 0); PG8_LDB(B1, 1, 1); PG8_SCHED; PG8_LDA(At, 1, 0); PG8_STAGE(PG8_SA(0, 1), a2 + hstepA, voffA);
            PG8_WAIT_V(8); PG8_WAIT_L(0); PG8_BAR; PG8_MMA(0, 0, At, B0); PG8_MMA(0, 1, At, B1); PG8_BAR; PG8_SCHED;
            PG8_LDA(At, 1, 1); PG8_STAGE(PG8_SB(1, 0), b3, voffB); PG8_STAGE(PG8_SB(1, 1), b3 + hstepB, voffB); PG8_STAGE(PG8_SA(1, 0), a3, voffA);
            PG8_WAIT_V(8); PG8_WAIT_L(0); PG8_BAR; PG8_MMA(1, 0, At, B0); PG8_MMA(1, 1, At, B1); PG8_BAR; PG8_SCHED;
            } else {
            PG8_LDB(B0, 0, 0); PG8_SCHED; PG8_LDA(At, 0, 0); PG8_STAGE(PG8_SA(1, 1), a1 + hstepA, voffA);
            PG8_WAIT_L(8); PG8_BAR; PG8_WAIT_L(0); PG8_MMA(0, 0, At, B0); PG8_BAR; PG8_SCHED;
            PG8_LDB(B1, 0, 1); PG8_STAGE(PG8_SB(0, 0), b2, voffB);
            PG8_BAR; PG8_WAIT_L(0); PG8_MMA(0, 1, At, B1); PG8_BAR;
            PG8_LDA(At, 0, 1); PG8_STAGE(PG8_SA(0, 0), a2, voffA);
            PG8_BAR; PG8_WAIT_L(0); PG8_MMA(1, 0, At, B0); PG8_BAR; PG8_SCHED;
            PG8_STAGE(PG8_SB(0, 1), b2 + hstepB, voffB);
            PG8_WAIT_V(6); PG8_BAR; PG8_MMA(1, 1, At, B1); PG8_BAR;
            PG8_LDB(B0, 1, 0); PG8_SCHED; PG8_LDA(At, 1, 0); PG8_STAGE(PG8_SA(0, 1), a2 + hstepA, voffA);
            PG8_WAIT_L(8); PG8_BAR; PG8_WAIT_L(0); PG8_MMA(0, 0, At, B0); PG8_BAR; PG8_SCHED;
            PG8_LDB(B1, 1, 1); PG8_STAGE(PG8_SB(1, 0), b3, voffB);
            PG8_BAR; PG8_WAIT_L(0); PG8_MMA(0, 1, At, B1); PG8_BAR;
            PG8_LDA(At, 1, 1); PG8_STAGE(PG8_SA(1, 0), a3, voffA);
            PG8_BAR; PG8_WAIT_L(0); PG8_MMA(1, 0, At, B0); PG8_BAR; PG8_SCHED;
            PG8_STAGE(PG8_SB(1, 1), b3 + hstepB, voffB);
            PG8_WAIT_V(6); PG8_BAR; PG8_MMA(1, 1, At, B1); PG8_BAR;
            }
        }
        if constexpr (ALIGN_EPI) { if (wr == 0) PG8_BAR; }
        if constexpr (!Epi::AFTER_DRAIN) { E.template run<0, 2>(acc, cur, wr, wc, fr, fq); S.done(cur); }
        if (!has_next) break;
#pragma unroll
        for (int a = 0; a < 2; ++a)
#pragma unroll
            for (int b = 0; b < 2; ++b)
#pragma unroll
                for (int m = 0; m < 4; ++m)
#pragma unroll
                    for (int n = 0; n < 2; ++n) acc[a][b][m][n] = (f32x4){0.f, 0.f, 0.f, 0.f};
        cur = nxt; cA = nA; cB = nB; ++ui;
        if constexpr (ALIGN_EPI) { if (wr == 1) PG8_BAR; }
    }
    PG8_WAIT_V(0);
    if constexpr (!ALIGN_EPI) { if (wr == 0) PG8_BAR; }
    PG8_BAR;
    if constexpr (Epi::AFTER_DRAIN) { E.fused(acc, cur, wr, wc, fr, fq, lds, wid, lane); S.done(cur); }
#undef PG8_SA
#undef PG8_SB
#undef PG8_STAGE
#undef PG8_LDA
#undef PG8_LDB
#undef PG8_MMA
#undef PG8_WAIT_V
#undef PG8_WAIT_L
#undef PG8_BAR
#undef PG8_SCHED
}

template <class Epi, class GemmT, class Sched>
__device__ __forceinline__ void gemm_phase_any(unsigned char* lds, const GemmT g, const Sched& S, const Epi& E) {
#if USE_MFMA_GEMM
    gemm_phase<Epi, Sched, GEMM_ALIGN, GEMM_SP2, GemmT>((PG8_LAS unsigned char*)lds, g, S, E);
#else
    gemm_simple<Epi, Sched, GemmT>(g, S, E);
#endif
}

__device__ __forceinline__ void q_fixup(float (&v)[8], int row, int col0, float rs, const f32x2* tab) {
#pragma unroll
    for (int i = 0; i < 8; ++i) v[i] *= rs;
    if (col0 >= 128 && row >= NCTX) { const int tpos = (row - NCTX) & (SEQ - 1), p0 = (col0 - 128) >> 1, axis = p0 >> 4, f0 = p0 & 15;
        const f32x2* tb = tab + (axis ? (tpos & 63) : (tpos >> 6)) * 16 + f0;
#pragma unroll
        for (int i = 0; i < 4; ++i) { const f32x2 t = tb[i]; const float a = v[2 * i], b = v[2 * i + 1]; v[2 * i] = a * t.x - b * t.y; v[2 * i + 1] = a * t.y + b * t.x; } }
}
__device__ __forceinline__ void attn_simple_unit(unsigned char* lds, const bf16_t* Q, const bf16_t* KL, bf16_t* O, const float* rstdq, const f32x2* tab, int qrow0, int h, int key0, int nkeys) {
    bf16_t* Qs = (bf16_t*)lds;
    float* Ks = (float*)(lds + 256 * 194 * 2);
    int t_l = threadIdx.x; asm volatile("" : "+v"(t_l));
    const int t = t_l, row = t >> 1, half = t & 1;
    __syncthreads();
    for (int i = t; i < 256 * 24; i += NTHREADS) { const int r = i / 24, c0 = (i % 24) * 8; const u32x4 q = *(const u32x4*)(Q + (size_t)(qrow0 + r) * QW + h * 192 + c0);
        float v[8] = {bflo(q.x), bfhi(q.x), bflo(q.y), bfhi(q.y), bflo(q.z), bfhi(q.z), bflo(q.w), bfhi(q.w)};
        q_fixup(v, qrow0 + r, c0, rstdq[qrow0 + r], tab);
#pragma unroll
        for (int k = 0; k < 8; k += 2) *(unsigned*)(Qs + r * 194 + c0 + k) = cvt_pk_bf16(v[k], v[k + 1]); }
    float m = -1e30f, l = 0.f, acc[64];
#pragma unroll
    for (int d = 0; d < 64; ++d) acc[d] = 0.f;
    for (int j0 = 0; j0 < nkeys; j0 += 16) {
        __syncthreads();
        for (int i = t; i < 16 * 192; i += NTHREADS) { const int j = i / 192, d = i % 192; Ks[j * 193 + d] = bf2f(KL[(size_t)(key0 + j0 + j) * KW + d]); }
        __syncthreads();
        float s[16];
#pragma unroll
        for (int j = 0; j < 16; ++j) s[j] = 0.f;
        for (int d = 0; d < 192; ++d) { const float qv = bf2f(Qs[row * 194 + d]);
#pragma unroll
            for (int j = 0; j < 16; ++j) s[j] += qv * Ks[j * 193 + d]; }
        float mx = s[0];
#pragma unroll
        for (int j = 1; j < 16; ++j) mx = fmaxf(mx, s[j]);
        const float mn = fmaxf(m, mx), alpha = exp2f(m - mn); m = mn;
        float ps = 0.f;
#pragma unroll
        for (int j = 0; j < 16; ++j) { s[j] = exp2f(s[j] - mn); ps += s[j]; }
        l = l * alpha + ps;
#pragma unroll
        for (int d = 0; d < 64; ++d) acc[d] *= alpha;
#pragma unroll 4
        for (int j = 0; j < 16; ++j) { const float p = bf2f((unsigned short)(cvt_pk_bf16(s[j], 0.f) & 0xffffu));
#pragma unroll
            for (int d = 0; d < 64; ++d) acc[d] += p * Ks[j * 193 + half * 64 + d]; }
    }
    const float rl = 1.f / l;
    bf16_t* o = O + (size_t)(qrow0 + row) * DM + h * 128 + half * 64;
#pragma unroll
    for (int d = 0; d < 64; d += 8) { u32x4 w; w.x = cvt_pk_bf16(acc[d] * rl, acc[d + 1] * rl); w.y = cvt_pk_bf16(acc[d + 2] * rl, acc[d + 3] * rl); w.z = cvt_pk_bf16(acc[d + 4] * rl, acc[d + 5] * rl); w.w = cvt_pk_bf16(acc[d + 6] * rl, acc[d + 7] * rl);
        *(u32x4*)(o + d) = w; }
}


namespace attn {
using s16x4 = __attribute__((ext_vector_type(4))) short;
#ifndef ATTN_NBUF
#define ATTN_NBUF 2
#endif
constexpr int NBUF = ATTN_NBUF;
constexpr int KROW = 400, SHM_V = 64 * 128 * 2, SHM_K = 64 * KROW, OFF_K = NBUF * SHM_V, OFF_WS = OFF_K + NBUF * SHM_K, LDS_NEED = OFF_WS + NWAVES * 64 * 4;
static_assert(LDS_NEED <= 131072, "attention LDS");
constexpr float THR2 = 8.f * 1.4426950408889634f;
#define SBAR() __builtin_amdgcn_sched_barrier(0)
__device__ __forceinline__ int crow(int r, int hi) { return (r & 3) + 8 * (r >> 2) + 4 * hi; }
template <int ABL> __device__ __forceinline__ void partialSM(f32x16& p0, f32x16& p1, float& m_reg, float& mn, float& alpha) {
  float pmax = p0[0]; for (int r = 1; r < 16; ++r) pmax = fmaxf(pmax, p0[r]); for (int r = 0; r < 16; ++r) pmax = fmaxf(pmax, p1[r]);
  { auto rr = __builtin_amdgcn_permlane32_swap(__float_as_uint(pmax), __float_as_uint(pmax), false, false);
    pmax = fmaxf(__uint_as_float(rr[0]), __uint_as_float(rr[1])); }
  if (__builtin_expect(__all(pmax - m_reg <= THR2), 1)) { mn = m_reg; alpha = 1.f; }
  else { mn = fmaxf(m_reg, pmax); alpha = __builtin_amdgcn_exp2f(m_reg - mn); m_reg = mn; }
  for (int r = 0; r < 16; ++r) p0[r] = p0[r] - mn; for (int r = 0; r < 16; ++r) p1[r] = p1[r] - mn;
  if (!(ABL & 1)) for (int r = 0; r < 16; ++r) p0[r] = __builtin_amdgcn_exp2f(p0[r]);
}
__device__ __forceinline__ void partialSM_negm(f32x16& p0, f32x16& p1, float& m_reg, float& alpha, f32x16& negm, bool first) {
  float pmax = p0[0]; for (int r = 1; r < 16; ++r) pmax = fmaxf(pmax, p0[r]); for (int r = 0; r < 16; ++r) pmax = fmaxf(pmax, p1[r]);
  { auto rr = __builtin_amdgcn_permlane32_swap(__float_as_uint(pmax), __float_as_uint(pmax), false, false);
    pmax = fmaxf(__uint_as_float(rr[0]), __uint_as_float(rr[1])); }
  if (__builtin_expect(!first && __all(pmax <= THR2), 1)) { alpha = 1.f; }
  else { const float dl = first ? pmax : fmaxf(pmax, 0.f); alpha = __builtin_amdgcn_exp2f(-fmaxf(dl, 0.f)); m_reg += dl; const float nm = -m_reg;
    for (int r = 0; r < 16; ++r) { p0[r] = p0[r] - dl; p1[r] = p1[r] - dl; negm[r] = nm; } }
  for (int r = 0; r < 16; ++r) p0[r] = __builtin_amdgcn_exp2f(p0[r]);
}
template <int ABL> __device__ __forceinline__ void finishSM(f32x16& p0, f32x16& p1, float alpha, float& l_reg, bf16x8& pa0, bf16x8& pa1, bf16x8& pa2, bf16x8& pa3) {
  if (!(ABL & 1)) for (int r = 0; r < 16; ++r) p1[r] = __builtin_amdgcn_exp2f(p1[r]);
  float ps = 0; for (int r = 0; r < 16; ++r) ps += p0[r]; for (int r = 0; r < 16; ++r) ps += p1[r];
  { auto rr = __builtin_amdgcn_permlane32_swap(__float_as_uint(ps), __float_as_uint(ps), false, false);
    ps = __uint_as_float(rr[0]) + __uint_as_float(rr[1]); }
  l_reg = l_reg * alpha + ps;
#if NATIVE_PV
#define PK4(P, BASE, OUT) do { u32x4 w = {cvt_pk_bf16(P[BASE + 0], P[BASE + 1]), cvt_pk_bf16(P[BASE + 2], P[BASE + 3]), cvt_pk_bf16(P[BASE + 4], P[BASE + 5]), cvt_pk_bf16(P[BASE + 6], P[BASE + 7])}; \
    OUT = *reinterpret_cast<bf16x8*>(&w); } while (0)
#else
#define PK4(P, BASE, OUT) do { unsigned a0 = cvt_pk_bf16(P[BASE + 0], P[BASE + 1]), a1 = cvt_pk_bf16(P[BASE + 2], P[BASE + 3]);   \
    unsigned b0 = cvt_pk_bf16(P[BASE + 4], P[BASE + 5]), b1 = cvt_pk_bf16(P[BASE + 6], P[BASE + 7]);                              \
    auto r0 = __builtin_amdgcn_permlane32_swap(a0, b0, false, false); auto r1 = __builtin_amdgcn_permlane32_swap(a1, b1, false, false); \
    u32x4 w = {r0[0], r1[0], r0[1], r1[1]}; OUT = *reinterpret_cast<bf16x8*>(&w); } while (0)
#endif
  PK4(p0, 0, pa0); PK4(p0, 8, pa1); PK4(p1, 0, pa2); PK4(p1, 8, pa3);
#undef PK4
}
template <int ABL> __device__ __forceinline__ void qkt(f32x16& p0, f32x16& p1, const char* Ks, const bf16x8* qr, int r32, int hi) {
  p0 = f32x16{}; p1 = f32x16{};
  if (ABL & 8) { asm volatile("" : "+v"(p0), "+v"(p1)); return; }
#pragma unroll
  for (int d0 = 0; d0 < 12; ++d0) { const int cb = (d0 * 16 + hi * 8) * 2;
    bf16x8 b0, b1;
    if (ABL & 16) { b0 = qr[(d0 + 1) % 12]; b1 = qr[(d0 + 2) % 12]; }
    else { b0 = *reinterpret_cast<const bf16x8*>(Ks + r32 * KROW + cb); b1 = *reinterpret_cast<const bf16x8*>(Ks + (32 + r32) * KROW + cb); }
    p0 = __builtin_amdgcn_mfma_f32_32x32x16_bf16(b0, qr[d0], p0, 0, 0, 0);
    p1 = __builtin_amdgcn_mfma_f32_32x32x16_bf16(b1, qr[d0], p1, 0, 0, 0); }
}
#ifndef QKD
#define QKD 4
#endif
template <int OFF> __device__ __forceinline__ bf16x8 lds_rd128(int addr) { bf16x8 r; asm volatile("ds_read_b128 %0, %1 offset:%2" : "=&v"(r) : "v"(addr), "i"(OFF) : "memory"); return r; }
template <int N> __device__ __forceinline__ void lgkm_wait() { asm volatile("s_waitcnt lgkmcnt(%0)" :: "i"(N) : "memory"); __builtin_amdgcn_sched_barrier(0); }
template <int D0> __device__ __forceinline__ void qk_step(f32x16& p0, f32x16& p1, bf16x8 (&f0)[12], bf16x8 (&f1)[12], const bf16x8* qr, int ka) {
  if constexpr (D0 + QKD < 12) { f0[D0 + QKD] = lds_rd128<(D0 + QKD) * 32>(ka); f1[D0 + QKD] = lds_rd128<32 * KROW + (D0 + QKD) * 32>(ka); }
  constexpr int AHEAD = (11 - D0) < QKD ? (11 - D0) : QKD;
  lgkm_wait<2 * AHEAD>();
  p0 = __builtin_amdgcn_mfma_f32_32x32x16_bf16(f0[D0], qr[D0], p0, 0, 0, 0);
  p1 = __builtin_amdgcn_mfma_f32_32x32x16_bf16(f1[D0], qr[D0], p1, 0, 0, 0);
  if constexpr (D0 + 1 < 12) qk_step<D0 + 1>(p0, p1, f0, f1, qr, ka);
}
__device__ __forceinline__ void qkt_asm(f32x16& p0, f32x16& p1, const char* Ks, const bf16x8* qr, int r32, int hi) {
  p0 = f32x16{}; p1 = f32x16{};
  const int ka = (int)(uintptr_t)Ks + r32 * KROW + hi * 16;
  bf16x8 f0[12], f1[12];
  f0[0] = lds_rd128<0>(ka); f1[0] = lds_rd128<32 * KROW>(ka);
  if constexpr (QKD > 1) { f0[1] = lds_rd128<32>(ka); f1[1] = lds_rd128<32 * KROW + 32>(ka); }
  if constexpr (QKD > 2) { f0[2] = lds_rd128<64>(ka); f1[2] = lds_rd128<32 * KROW + 64>(ka); }
  if constexpr (QKD > 3) { f0[3] = lds_rd128<96>(ka); f1[3] = lds_rd128<32 * KROW + 96>(ka); }
  if constexpr (QKD > 4) { f0[4] = lds_rd128<128>(ka); f1[4] = lds_rd128<32 * KROW + 128>(ka); }
  if constexpr (QKD > 5) { f0[5] = lds_rd128<160>(ka); f1[5] = lds_rd128<32 * KROW + 160>(ka); }
  qk_step<0>(p0, p1, f0, f1, qr, ka);
}
constexpr int KROW2 = 384, SHM_K2 = 64 * KROW2;
template <int D0> __device__ __forceinline__ void qk_step2(f32x16& p0, f32x16& p1, bf16x8 (&f0)[12], bf16x8 (&f1)[12], const bf16x8* qr, const int (&ka)[4]) {
  if constexpr (D0 + QKD < 12) { constexpr int E = D0 + QKD; f0[E] = lds_rd128<(E >> 2) * 128>(ka[E & 3]); f1[E] = lds_rd128<32 * KROW2 + (E >> 2) * 128>(ka[E & 3]); }
  constexpr int AHEAD = (11 - D0) < QKD ? (11 - D0) : QKD;
  lgkm_wait<2 * AHEAD>();
  p0 = __builtin_amdgcn_mfma_f32_32x32x16_bf16(f0[D0], qr[D0], p0, 0, 0, 0);
  p1 = __builtin_amdgcn_mfma_f32_32x32x16_bf16(f1[D0], qr[D0], p1, 0, 0, 0);
  if constexpr (D0 + 1 < 12) qk_step2<D0 + 1>(p0, p1, f0, f1, qr, ka);
}
__device__ __forceinline__ void qkt_asm2(f32x16& p0, f32x16& p1, int kb, int t, const bf16x8* qr) {
  p0 = f32x16{}; p1 = f32x16{};
  const int ka[4] = {kb + ((0 ^ t) << 5), kb + ((1 ^ t) << 5), kb + ((2 ^ t) << 5), kb + ((3 ^ t) << 5)};
  bf16x8 f0[12], f1[12];
  f0[0] = lds_rd128<0>(ka[0]); f1[0] = lds_rd128<32 * KROW2>(ka[0]);
  if constexpr (QKD > 1) { f0[1] = lds_rd128<0>(ka[1]); f1[1] = lds_rd128<32 * KROW2>(ka[1]); }
  if constexpr (QKD > 2) { f0[2] = lds_rd128<0>(ka[2]); f1[2] = lds_rd128<32 * KROW2>(ka[2]); }
  if constexpr (QKD > 3) { f0[3] = lds_rd128<0>(ka[3]); f1[3] = lds_rd128<32 * KROW2>(ka[3]); }
  static_assert(QKD <= 4, "qkt_asm2 prefetch depth");
  qk_step2<0>(p0, p1, f0, f1, qr, ka);
}
__device__ __forceinline__ int v_st(int k, int c) { const int kk = NATIVE_PV ? k : ((k & ~0xC) | ((k & 4) << 1) | ((k & 8) >> 1)); return ((kk >> 3) * 4 + (c >> 5)) * 512 + ((kk & 7) * 32 + (c & 31)) * 2; }
__device__ __forceinline__ int v_rd_base(int lane) { return ((lane & 3) << 3) | (((lane >> 2) & 3) << 6) | (((lane >> 4) & 1) << 5) | (((lane >> 5) & 1) << 8); }
constexpr int v_rd_off(int d0, int ks, int half) { return d0 * 512 + ks * 4096 + half * 2048; }
template <int OFF> __device__ __forceinline__ s16x4 tr_read(int vb) {
  s16x4 r; asm volatile("ds_read_b64_tr_b16 %0, %1 offset:%2" : "=&v"(r) : "v"(vb), "i"(OFF) : "memory"); return r;
}
template <int D0, int ABL = 0> __device__ __forceinline__ void pv_one(f32x16& od, int vb, bf16x8 pa0, bf16x8 pa1, bf16x8 pa2, bf16x8 pa3) {
  if (ABL & 16) { od = __builtin_amdgcn_mfma_f32_32x32x16_bf16(pa0, pa1, od, 0, 0, 0); od = __builtin_amdgcn_mfma_f32_32x32x16_bf16(pa1, pa2, od, 0, 0, 0); od = __builtin_amdgcn_mfma_f32_32x32x16_bf16(pa2, pa3, od, 0, 0, 0); od = __builtin_amdgcn_mfma_f32_32x32x16_bf16(pa3, pa0, od, 0, 0, 0); return; }
  const s16x4 l0 = tr_read<v_rd_off(D0, 0, 0)>(vb), h0 = tr_read<v_rd_off(D0, 0, 1)>(vb), l1 = tr_read<v_rd_off(D0, 1, 0)>(vb), h1 = tr_read<v_rd_off(D0, 1, 1)>(vb);
  const s16x4 l2 = tr_read<v_rd_off(D0, 2, 0)>(vb), h2 = tr_read<v_rd_off(D0, 2, 1)>(vb), l3 = tr_read<v_rd_off(D0, 3, 0)>(vb), h3 = tr_read<v_rd_off(D0, 3, 1)>(vb);
  asm volatile("s_waitcnt lgkmcnt(0)" ::: "memory"); SBAR();
#define PK(L, H) (bf16x8){L[0], L[1], L[2], L[3], H[0], H[1], H[2], H[3]}
  od = __builtin_amdgcn_mfma_f32_32x32x16_bf16(pa0, PK(l0, h0), od, 0, 0, 0);
  od = __builtin_amdgcn_mfma_f32_32x32x16_bf16(pa1, PK(l1, h1), od, 0, 0, 0);
  od = __builtin_amdgcn_mfma_f32_32x32x16_bf16(pa2, PK(l2, h2), od, 0, 0, 0);
  od = __builtin_amdgcn_mfma_f32_32x32x16_bf16(pa3, PK(l3, h3), od, 0, 0, 0);
#undef PK
}
template <int ABL> __device__ __forceinline__ void pv_d0(f32x16* o, int vb, bf16x8 pa0, bf16x8 pa1, bf16x8 pa2, bf16x8 pa3) {
  if (ABL & 4) { asm volatile("" :: "v"(pa0), "v"(pa1), "v"(pa2), "v"(pa3)); return; }
  pv_one<0, ABL>(o[0], vb, pa0, pa1, pa2, pa3); pv_one<1, ABL>(o[1], vb, pa0, pa1, pa2, pa3); pv_one<2, ABL>(o[2], vb, pa0, pa1, pa2, pa3); pv_one<3, ABL>(o[3], vb, pa0, pa1, pa2, pa3);
}
template <int B> __device__ __forceinline__ void v_rd_blk(s16x4 (&vl)[4][4], s16x4 (&vh)[4][4], int vb) {
  vl[B][0] = tr_read<v_rd_off(B, 0, 0)>(vb); vh[B][0] = tr_read<v_rd_off(B, 0, 1)>(vb); vl[B][1] = tr_read<v_rd_off(B, 1, 0)>(vb); vh[B][1] = tr_read<v_rd_off(B, 1, 1)>(vb);
  vl[B][2] = tr_read<v_rd_off(B, 2, 0)>(vb); vh[B][2] = tr_read<v_rd_off(B, 2, 1)>(vb); vl[B][3] = tr_read<v_rd_off(B, 3, 0)>(vb); vh[B][3] = tr_read<v_rd_off(B, 3, 1)>(vb);
}
template <int B> __device__ __forceinline__ void pv_blk(f32x16& od, const s16x4 (&vl)[4][4], const s16x4 (&vh)[4][4], bf16x8 pa0, bf16x8 pa1, bf16x8 pa2, bf16x8 pa3) {
#define PKV(k) (bf16x8){vl[B][k][0], vl[B][k][1], vl[B][k][2], vl[B][k][3], vh[B][k][0], vh[B][k][1], vh[B][k][2], vh[B][k][3]}
  od = __builtin_amdgcn_mfma_f32_32x32x16_bf16(pa0, PKV(0), od, 0, 0, 0); od = __builtin_amdgcn_mfma_f32_32x32x16_bf16(pa1, PKV(1), od, 0, 0, 0);
  od = __builtin_amdgcn_mfma_f32_32x32x16_bf16(pa2, PKV(2), od, 0, 0, 0); od = __builtin_amdgcn_mfma_f32_32x32x16_bf16(pa3, PKV(3), od, 0, 0, 0);
#undef PKV
}
template <int D> __device__ __forceinline__ void k_rd_blk(bf16x8 (&f0)[12], bf16x8 (&f1)[12], const int (&ka)[4]) { f0[D] = lds_rd128<(D >> 2) * 128>(ka[D & 3]); f1[D] = lds_rd128<32 * KROW2 + (D >> 2) * 128>(ka[D & 3]); }
template <bool PVF, bool QKF>
__device__ __forceinline__ void m_seg(f32x16& p0, f32x16& p1, f32x16* o, bf16x8 pa0, bf16x8 pa1, bf16x8 pa2, bf16x8 pa3, int kb, int kt, int vb, const bf16x8* qr, const f32x16& negm) {
  static_assert(QKD == 4, "m_seg assumes QKD == 4");
  const int ka[4] = {kb + ((0 ^ kt) << 5), kb + ((1 ^ kt) << 5), kb + ((2 ^ kt) << 5), kb + ((3 ^ kt) << 5)};
  bf16x8 f0[12], f1[12]; s16x4 vl[4][4], vh[4][4];
  SBAR();
  if (PVF) { v_rd_blk<0>(vl, vh, vb); v_rd_blk<1>(vl, vh, vb); }
  if (QKF) { k_rd_blk<0>(f0, f1, ka); k_rd_blk<1>(f0, f1, ka); }
  if (PVF) {
    lgkm_wait<8 + (QKF ? 4 : 0)>(); pv_blk<0>(o[0], vl, vh, pa0, pa1, pa2, pa3); v_rd_blk<2>(vl, vh, vb); SBAR();
    lgkm_wait<8 + (QKF ? 4 : 0)>(); pv_blk<1>(o[1], vl, vh, pa0, pa1, pa2, pa3); v_rd_blk<3>(vl, vh, vb); SBAR();
    lgkm_wait<8>(); pv_blk<2>(o[2], vl, vh, pa0, pa1, pa2, pa3); if (QKF) { k_rd_blk<2>(f0, f1, ka); k_rd_blk<3>(f0, f1, ka); } SBAR();
    lgkm_wait<(QKF ? 4 : 0)>(); pv_blk<3>(o[3], vl, vh, pa0, pa1, pa2, pa3); SBAR();
  } else if (QKF) { k_rd_blk<2>(f0, f1, ka); k_rd_blk<3>(f0, f1, ka); }
#if SM_NEGM
  if (QKF) {
    if constexpr (QKD + 0 < 12) { f0[QKD] = lds_rd128<(QKD >> 2) * 128>(ka[QKD & 3]); f1[QKD] = lds_rd128<32 * KROW2 + (QKD >> 2) * 128>(ka[QKD & 3]); }
    lgkm_wait<2 * QKD>();
    p0 = __builtin_amdgcn_mfma_f32_32x32x16_bf16(f0[0], qr[0], negm, 0, 0, 0);
    p1 = __builtin_amdgcn_mfma_f32_32x32x16_bf16(f1[0], qr[0], negm, 0, 0, 0);
    qk_step2<1>(p0, p1, f0, f1, qr, ka); }
#else
  if (QKF) { p0 = f32x16{}; p1 = f32x16{}; qk_step2<0>(p0, p1, f0, f1, qr, ka); }
#endif
}
#ifndef ATTN_SDEPTH
#define ATTN_SDEPTH 2
#endif
constexpr int SDEPTH = ATTN_SDEPTH;
template <int ABL = 0> __device__ __forceinline__ void unit(char* lds, const bf16_t* __restrict__ Qg, const bf16_t* __restrict__ Kb, bf16_t* __restrict__ Og, const float* rstdq, const f32x2* tab,
                                     int qrow0, int h, int nkeys) {
  int tid_l = threadIdx.x; asm volatile("" : "+v"(tid_l));
  const int tid = tid_l, wid = tid >> 6, lane = tid & 63, r32 = lane & 31, hi = lane >> 5;
  char* V_lds = lds; char* K_lds = lds + OFF_K;
  float* ws = (float*)(lds + OFF_WS) + wid * 64; float* li_l = ws; float* al_l = ws + 32;
  float m_reg = -1e30f, l_reg = 0; f32x16 o[4] = {}; bf16x8 qr[12];
  { const int row = qrow0 + wid * 32 + r32; const float rs = rstdq[row]; const bf16_t* Qw = Qg + (size_t)row * QW + h * 192 + hi * 8;
#pragma unroll
    for (int d0 = 0; d0 < 12; ++d0) { const u32x4 q = *(const u32x4*)(Qw + d0 * 16);
      float v[8] = {bflo(q.x), bfhi(q.x), bflo(q.y), bfhi(q.y), bflo(q.z), bfhi(q.z), bflo(q.w), bfhi(q.w)};
      q_fixup(v, row, d0 * 16 + hi * 8, rs, tab);
      u32x4 w = {cvt_pk_bf16(v[0], v[1]), cvt_pk_bf16(v[2], v[3]), cvt_pk_bf16(v[4], v[5]), cvt_pk_bf16(v[6], v[7])}; qr[d0] = *reinterpret_cast<bf16x8*>(&w); } }
  const int sr = tid >> 4, sc = (tid & 15) * 8, vst0 = v_st(sr, sc), vst1 = v_st(32 + sr, sc);
  const int kst0 = sr * KROW + sc * 2, kst1 = (32 + sr) * KROW + sc * 2, rr = tid >> 3, rc = 128 + (tid & 7) * 8, kst2 = rr * KROW + rc * 2;
  const int vb0 = (int)(uintptr_t)V_lds + v_rd_base(lane);
  struct { bf16x8 ks0, ks1, kr; } sr_[SDEPTH];
#define SLOAD(i, k0) do { if ((ABL & 2) && (k0) > 128) break; sr_[i].ks0 = *(const bf16x8*)(Kb + (size_t)((k0) + sr) * KW + sc); sr_[i].ks1 = *(const bf16x8*)(Kb + (size_t)((k0) + 32 + sr) * KW + sc); \
    sr_[i].kr = *(const bf16x8*)(Kb + (size_t)((k0) + rr) * KW + rc); } while (0)
#define SWRITE(b, i) do { if ((ABL & 2) && nowrite) break; *(bf16x8*)(V_lds + (b) * SHM_V + vst0) = sr_[i].ks0; *(bf16x8*)(V_lds + (b) * SHM_V + vst1) = sr_[i].ks1; \
    *(bf16x8*)(K_lds + (b) * SHM_K + kst0) = sr_[i].ks0; *(bf16x8*)(K_lds + (b) * SHM_K + kst1) = sr_[i].ks1; *(bf16x8*)(K_lds + (b) * SHM_K + kst2) = sr_[i].kr; } while (0)
#define LSYNC() do { if (!(ABL & 2)) __syncthreads(); } while (0)
#define SWAIT() do { if (ABL & 2) break; if (SDEPTH == 2) asm volatile("s_waitcnt vmcnt(3)" ::: "memory"); else asm volatile("s_waitcnt vmcnt(0)" ::: "memory"); } while (0)
#define RESC(a) do { if (__any((a) < 1.f)) { if (hi == 0) al_l[r32] = (a); asm volatile("s_waitcnt lgkmcnt(0)" ::: "memory"); \
    for (int d = 0; d < 4; ++d) for (int r = 0; r < 16; ++r) o[d][r] *= al_l[crow(r, hi)]; } } while (0)
  bool nowrite = false;
  f32x16 pA0, pA1, pB0, pB1; float mnA, mnB, alA, alB; bf16x8 pa0, pa1, pa2, pa3; const int NT = nkeys / 64;
  constexpr int SE = 0, SO = SDEPTH - 1;
  __syncthreads();
  SLOAD(SE, 0); asm volatile("s_waitcnt vmcnt(0)" ::: "memory"); SWRITE(0, SE); __syncthreads();
  qkt<ABL>(pA0, pA1, K_lds, qr, r32, hi); partialSM<ABL>(pA0, pA1, m_reg, mnA, alA);
  SLOAD(SO, 64); if (SDEPTH == 2 && 2 < NT) SLOAD(SE, 2 * 64);
  if (2 < NT) SWAIT(); else asm volatile("s_waitcnt vmcnt(0)" ::: "memory");
  SWRITE(1, SO); __syncthreads();
  nowrite = true;
  int ib_qk = 1, ib_pv = 0, ib_wr = (NBUF == 3) ? 2 : 0;
#define ROT() do { ib_pv = ib_qk; ib_qk = ib_wr; ib_wr = (NBUF == 3) ? (ib_wr == 2 ? 0 : ib_wr + 1) : (ib_wr ^ 1); } while (0)
#define PRE_WRITE_SYNC() do { if (NBUF == 2) LSYNC(); } while (0)
  for (int j = 1; j + 1 < NT; j += 2) {
    SBAR(); qkt<ABL>(pB0, pB1, K_lds + ib_qk * SHM_K, qr, r32, hi);
    finishSM<ABL>(pA0, pA1, alA, l_reg, pa0, pa1, pa2, pa3); SBAR();
    SLOAD(SO, (j + SDEPTH) * 64); SBAR();
    pv_d0<ABL>(o, vb0 + ib_pv * SHM_V, pa0, pa1, pa2, pa3); partialSM<ABL>(pB0, pB1, m_reg, mnB, alB);
    PRE_WRITE_SYNC(); SWAIT(); SWRITE(ib_wr, SE);
    RESC(alB); LSYNC(); ROT();
    SBAR(); qkt<ABL>(pA0, pA1, K_lds + ib_qk * SHM_K, qr, r32, hi);
    finishSM<ABL>(pB0, pB1, alB, l_reg, pa0, pa1, pa2, pa3); SBAR();
    if (SDEPTH == 1 || j + 3 < NT) SLOAD(SE, (j + 1 + SDEPTH) * 64); SBAR();
    pv_d0<ABL>(o, vb0 + ib_pv * SHM_V, pa0, pa1, pa2, pa3); partialSM<ABL>(pA0, pA1, m_reg, mnA, alA);
    PRE_WRITE_SYNC(); if (SDEPTH == 2 && j + 3 < NT) SWAIT(); else asm volatile("s_waitcnt vmcnt(0)" ::: "memory");
    SWRITE(ib_wr, SO);
    RESC(alA); LSYNC(); ROT();
  }
  SBAR(); qkt<ABL>(pB0, pB1, K_lds + ib_qk * SHM_K, qr, r32, hi);
  finishSM<ABL>(pA0, pA1, alA, l_reg, pa0, pa1, pa2, pa3); SBAR();
  pv_d0<ABL>(o, vb0 + ib_pv * SHM_V, pa0, pa1, pa2, pa3); partialSM<ABL>(pB0, pB1, m_reg, mnB, alB);
  __syncthreads(); RESC(alB);
  finishSM<ABL>(pB0, pB1, alB, l_reg, pa0, pa1, pa2, pa3); SBAR();
  pv_d0<ABL>(o, vb0 + ib_qk * SHM_V, pa0, pa1, pa2, pa3);
#undef ROT
#undef PRE_WRITE_SYNC
  if (hi == 0) li_l[r32] = l_reg; asm volatile("s_waitcnt lgkmcnt(0)" ::: "memory");
  bf16_t* Ow = Og + (size_t)(qrow0 + wid * 32) * DM + h * 128;
  const bool odd = lane & 1;
#pragma unroll
  for (int r = 0; r < 16; r += 2) { const float ra = __builtin_amdgcn_rcpf(li_l[crow(r, hi)]), rb = __builtin_amdgcn_rcpf(li_l[crow(r + 1, hi)]);
#pragma unroll
    for (int d0 = 0; d0 < 4; ++d0) { const float a = o[d0][r] * ra, b = o[d0][r + 1] * rb;
      const float recv = __shfl_xor(odd ? a : b, 1);
      const unsigned w = odd ? cvt_pk_bf16(recv, b) : cvt_pk_bf16(a, recv);
      const int orow = crow(odd ? r + 1 : r, hi);
      *(unsigned*)(Ow + (size_t)orow * DM + d0 * 32 + (r32 & ~1)) = w; } }
#undef SLOAD
#undef SWRITE
#undef SWAIT
#undef LSYNC
#undef RESC
}
#undef SBAR
}


namespace attn2 {
using namespace attn;
#define SBAR() __builtin_amdgcn_sched_barrier(0)
template <bool GX, int AB2 = 0>
__device__ __forceinline__ void unit(char* lds, const bf16_t* __restrict__ Qg, const bf16_t* __restrict__ Kb, bf16_t* __restrict__ Og, const float* rstdq, const f32x2* tab,
                                     int qrow0, int h, int nkeys) {
  int tid_l = threadIdx.x; asm volatile("" : "+v"(tid_l));
  const int tid = tid_l, wid = tid >> 6, lane = tid & 63, r32 = lane & 31, hi = lane >> 5;
  const int lw = ATTN2_GSEL == 0 ? (wid & 3) : ATTN2_GSEL == 1 ? (wid >> 1) : ((wid & 1) | ((wid >> 2) << 1)), gt = lw * 64 + lane;
  constexpr int SHK = ATTN2_DMA ? SHM_K2 : SHM_K;
  char* V_lds = lds; char* K_lds = lds + 2 * SHM_V;
  float* ws = (float*)(lds + 2 * SHM_V + 2 * SHK) + wid * 64; float* li_l = ws; float* al_l = ws + 32;
  float m_reg = -1e30f, l_reg = 0; f32x16 o[4] = {}; bf16x8 qr[12];
  { const int row = qrow0 + wid * 32 + r32; const float rs = rstdq[row]; const bf16_t* Qw = Qg + (size_t)row * QW + h * 192 + hi * 8;
#pragma unroll
    for (int d0 = 0; d0 < 12; ++d0) { const u32x4 q = *(const u32x4*)(Qw + d0 * 16);
      float v[8] = {bflo(q.x), bfhi(q.x), bflo(q.y), bfhi(q.y), bflo(q.z), bfhi(q.z), bflo(q.w), bfhi(q.w)};
      q_fixup(v, row, d0 * 16 + hi * 8, rs, tab);
      u32x4 w = {cvt_pk_bf16(v[0], v[1]), cvt_pk_bf16(v[2], v[3]), cvt_pk_bf16(v[4], v[5]), cvt_pk_bf16(v[6], v[7])}; qr[d0] = *reinterpret_cast<bf16x8*>(&w); } }
  const int vb0 = (int)(uintptr_t)V_lds + v_rd_base(lane);
#if ATTN2_DMA
  const int lwu = __builtin_amdgcn_readfirstlane(lw);
  unsigned koff[GX ? 6 : 1];
  if (GX) {
#pragma unroll
    for (int j = 0; j < 6; ++j) { const int q = 64 * (j % 3) + lane, rr = q / 24, cc = q - 24 * rr, r = 8 * (2 * lw + j / 3) + rr; koff[j] = (unsigned)(r * 384 + ((cc ^ ((r >> 1) & 7)) << 4)); }
  } else koff[0] = (unsigned)((((gt >> 7) * 8 + ((gt >> 2) & 7)) * 384) + ((gt >> 5) & 3) * 64 + (gt & 3) * 16);
  const int sw_ = (r32 >> 1) & 7, kb0 = (int)(uintptr_t)K_lds + r32 * KROW2 + ((hi ^ (sw_ & 1)) << 4), kt = sw_ >> 1;
#define DMA_K(t) do { const char* src_ = (const char*)Kb + (size_t)(t) * (64 * KW * 2); char* dst_ = K_lds + ((t) & 1) * SHM_K2 + lwu * 6144; \
    _Pragma("unroll") for (int j = 0; j < 6; ++j) __builtin_amdgcn_global_load_lds((const unsigned*)(src_ + koff[j]), (__attribute__((address_space(3))) unsigned*)(dst_ + j * 1024), 16, 0, 0); } while (0)
#define DMA_V(t) do { const char* src_ = (const char*)Kb + (size_t)(t) * (64 * KW * 2) + koff[0]; char* dst_ = V_lds + ((t) & 1) * SHM_V + lwu * 1024; \
    _Pragma("unroll") for (int i = 0; i < 4; ++i) __builtin_amdgcn_global_load_lds((const unsigned*)(src_ + i * (16 * KW * 2)), (__attribute__((address_space(3))) unsigned*)(dst_ + i * 4096), 16, 0, 0); } while (0)
#define VM0() asm volatile("s_waitcnt vmcnt(0)" ::: "memory")
#define QKT(k) qkt_asm2(p0, p1, kb0 + ((k) & 1) * SHM_K2, kt, qr)
#else
#define QKT(k) qkt_asm(p0, p1, K_lds + ((k) & 1) * SHM_K, qr, r32, hi)
#endif
  constexpr int NCH = ATTN2_DMA ? 1 : (GX ? 6 : 4);
  bf16x8 stg[NCH];
#define STAGE_LOAD(t) do { _Pragma("unroll") for (int i = 0; i < NCH; ++i) { const int id = gt + 256 * i; \
    stg[i] = GX ? *(const bf16x8*)(Kb + (size_t)(t) * 64 * KW + id * 8) : *(const bf16x8*)(Kb + (size_t)((t) * 64 + (id >> 4)) * KW + (id & 15) * 8); } } while (0)
#define STAGE_WRITE(t) do { _Pragma("unroll") for (int i = 0; i < NCH; ++i) { const int id = gt + 256 * i; \
    if (GX) { const int key = (id * 2731) >> 16; *(bf16x8*)(K_lds + ((t) & 1) * SHM_K + id * 16 + key * 16) = stg[i]; } \
    else *(bf16x8*)(V_lds + ((t) & 1) * SHM_V + v_st(id >> 4, (id & 15) * 8)) = stg[i]; } } while (0)
#define RESC(a) do { if (__any((a) < 1.f)) { if (hi == 0) al_l[r32] = (a); asm volatile("s_waitcnt lgkmcnt(0)" ::: "memory"); \
    for (int d = 0; d < 4; ++d) for (int r = 0; r < 16; ++r) o[d][r] *= al_l[crow(r, hi)]; } } while (0)
  f32x16 p0 = {}, p1 = {}; float mn = 0.f, al = 1.f; bf16x8 pa0 = {}, pa1 = {}, pa2 = {}, pa3 = {}; const int NT = nkeys / 64;
  __syncthreads();
#if ATTN2_DMA
  if (GX) { DMA_K(0); VM0(); }
#else
  if (GX) { STAGE_LOAD(0); STAGE_WRITE(0); }
#endif
  __syncthreads();
#if ATTN2_DMA && ATTN2_MSEG
#define MSEG(PVF, QKF, k) m_seg<PVF, QKF>(p0, p1, o, pa0, pa1, pa2, pa3, kb0 + ((k) & 1) * SHM_K2, kt, vb0 + (((k) - 1) & 1) * SHM_V, qr, negm)
#if SM_NEGM
  f32x16 negm = {}; bool first = true; m_reg = 0.f;
#define SOFTMAX() do { partialSM_negm(p0, p1, m_reg, al, negm, first); first = false; RESC(al); finishSM<0>(p0, p1, al, l_reg, pa0, pa1, pa2, pa3); } while (0)
#else
  const f32x16 negm = {};
#define SOFTMAX() do { partialSM<0>(p0, p1, m_reg, mn, al); RESC(al); finishSM<0>(p0, p1, al, l_reg, pa0, pa1, pa2, pa3); } while (0)
#endif
  if (GX) {
    if (1 < NT) DMA_K(1); SBAR(); MSEG(false, true, 0); __syncthreads();
    SBAR(); SOFTMAX(); SBAR(); VM0(); __syncthreads();
    for (int k = 1; k < NT; ++k) {
      if (k + 1 < NT) DMA_K(k + 1); SBAR(); MSEG(true, true, k); __syncthreads();
      SBAR(); SOFTMAX(); SBAR(); VM0(); __syncthreads();
    }
    MSEG(true, false, NT); __syncthreads(); __syncthreads();
  } else {
    DMA_V(0); __syncthreads();
    SBAR(); MSEG(false, true, 0); VM0(); __syncthreads();
    for (int k = 1; k < NT; ++k) {
      DMA_V(k); SBAR(); SOFTMAX(); SBAR(); __syncthreads();
      SBAR(); MSEG(true, true, k); VM0(); __syncthreads();
    }
    SBAR(); SOFTMAX(); SBAR(); __syncthreads();
    MSEG(true, false, NT); __syncthreads();
  }
#undef MSEG
#undef SOFTMAX
#else
  for (int k = 0; k <= NT; ++k) {
    if (GX) {
      __builtin_amdgcn_s_setprio(ATTN2_PM); SBAR();
#if ATTN2_DMA
      if (k + 1 < NT) DMA_K(k + 1);
      SBAR();
#endif
#if ATTN2_DMA && ATTN2_MSEG
      { const int kbk = kb0 + (k & 1) * SHM_K2, vbk = vb0 + ((k - 1) & 1) * SHM_V;
        if (k >= 1 && k < NT) m_seg<true, true>(p0, p1, o, pa0, pa1, pa2, pa3, kbk, kt, vbk, qr); else if (k < NT) m_seg<false, true>(p0, p1, o, pa0, pa1, pa2, pa3, kbk, kt, vbk, qr); else m_seg<true, false>(p0, p1, o, pa0, pa1, pa2, pa3, kbk, kt, vbk, qr); }
#else
      if (k >= 1) { if (!(AB2 & 2)) pv_d0<0>(o, vb0 + ((k - 1) & 1) * SHM_V, pa0, pa1, pa2, pa3); else { asm volatile("" :: "v"(pa0), "v"(pa1), "v"(pa2), "v"(pa3)); asm volatile("" : "+v"(o[0]), "+v"(o[1]), "+v"(o[2]), "+v"(o[3])); } }
      if (k < NT) { if (!(AB2 & 2)) QKT(k); else asm volatile("" : "+v"(p0), "+v"(p1)); }
#endif
      __syncthreads();
      __builtin_amdgcn_s_setprio(ATTN2_PV); SBAR();
#if !ATTN2_DMA
      if (k + 1 < NT) STAGE_LOAD(k + 1);
#endif
      SBAR();
      if (k < NT) { if (!(AB2 & 1)) { partialSM<0>(p0, p1, m_reg, mn, al); RESC(al); finishSM<0>(p0, p1, al, l_reg, pa0, pa1, pa2, pa3); } else { asm volatile("" :: "v"(p0), "v"(p1)); asm volatile("" : "+v"(pa0), "+v"(pa1), "+v"(pa2), "+v"(pa3)); } }
      SBAR();
#if ATTN2_DMA
      VM0();
#else
      if (k + 1 < NT) STAGE_WRITE(k + 1);
#endif
      __syncthreads();
    } else {
      __builtin_amdgcn_s_setprio(ATTN2_PV); SBAR();
#if ATTN2_DMA
      if (k < NT) DMA_V(k);
#else
      if (k < NT) STAGE_LOAD(k);
#endif
      SBAR();
      if (k >= 1) { if (!(AB2 & 1)) { partialSM<0>(p0, p1, m_reg, mn, al); RESC(al); finishSM<0>(p0, p1, al, l_reg, pa0, pa1, pa2, pa3); } else { asm volatile("" :: "v"(p0), "v"(p1)); asm volatile("" : "+v"(pa0), "+v"(pa1), "+v"(pa2), "+v"(pa3)); } }
      SBAR();
#if !ATTN2_DMA
      if (k < NT) STAGE_WRITE(k);
#endif
      __syncthreads();
      __builtin_amdgcn_s_setprio(ATTN2_PM); SBAR();
#if ATTN2_DMA && ATTN2_MSEG
      { const int kbk = kb0 + (k & 1) * SHM_K2, vbk = vb0 + ((k - 1) & 1) * SHM_V;
        if (k >= 1 && k < NT) m_seg<true, true>(p0, p1, o, pa0, pa1, pa2, pa3, kbk, kt, vbk, qr); else if (k < NT) m_seg<false, true>(p0, p1, o, pa0, pa1, pa2, pa3, kbk, kt, vbk, qr); else m_seg<true, false>(p0, p1, o, pa0, pa1, pa2, pa3, kbk, kt, vbk, qr); }
#else
      if (k >= 1) { if (!(AB2 & 2)) pv_d0<0>(o, vb0 + ((k - 1) & 1) * SHM_V, pa0, pa1, pa2, pa3); else { asm volatile("" :: "v"(pa0), "v"(pa1), "v"(pa2), "v"(pa3)); asm volatile("" : "+v"(o[0]), "+v"(o[1]), "+v"(o[2]), "+v"(o[3])); } }
      if (k < NT) { if (!(AB2 & 2)) QKT(k); else asm volatile("" : "+v"(p0), "+v"(p1)); }
#endif
#if ATTN2_DMA
      VM0();
#endif
      __syncthreads();
    }
  }
#endif
  __builtin_amdgcn_s_setprio(0);
  if (hi == 0) li_l[r32] = l_reg; asm volatile("s_waitcnt lgkmcnt(0)" ::: "memory");
  bf16_t* Ow = Og + (size_t)(qrow0 + wid * 32) * DM + h * 128;
  const bool odd = lane & 1;
#pragma unroll
  for (int r = 0; r < 16; r += 2) { const float ra = __builtin_amdgcn_rcpf(li_l[crow(r, hi)]), rb = __builtin_amdgcn_rcpf(li_l[crow(r + 1, hi)]);
#pragma unroll
    for (int d0 = 0; d0 < 4; ++d0) { const float a = o[d0][r] * ra, b = o[d0][r + 1] * rb;
      const float recv = __shfl_xor(odd ? a : b, 1);
      const unsigned w = odd ? cvt_pk_bf16(recv, b) : cvt_pk_bf16(a, recv);
      const int orow = crow(odd ? r + 1 : r, hi);
      *(unsigned*)(Ow + (size_t)orow * DM + d0 * 32 + (r32 & ~1)) = w; } }
#undef STAGE_LOAD
#undef STAGE_WRITE
#undef RESC
#undef QKT
#if ATTN2_DMA
#undef DMA_K
#undef DMA_V
#undef VM0
#endif
}
#undef SBAR
}

template <class Src>
__device__ __forceinline__ void transpose_item(bf16_t* WT, int K, int item, int nblk, float* scr, int lane, const Src& src, const bool NTS = false) {
    const int kb = item / nblk, nb = item % nblk, k0 = 64 * kb, n0 = 32 * nb;
    float tv[32];
#pragma unroll
    for (int i = 0; i < 32; ++i) tv[i] = src(k0 + 2 * i + (lane >> 5), n0 + (lane & 31));
#pragma unroll
    for (int i = 0; i < 32; ++i) { const int kk = 2 * i + (lane >> 5); scr[kk * 33 + (lane & 31)] = tv[i]; }
    asm volatile("s_waitcnt lgkmcnt(0)" ::: "memory");
    const int c = lane & 7;
#pragma unroll
    for (int j = 0; j < 4; ++j) { const int n = (lane >> 3) + 8 * j; const float* s = scr + (8 * c) * 33 + n;
        u32x4 o; o.x = cvt_pk_bf16(s[0 * 33], s[1 * 33]); o.y = cvt_pk_bf16(s[2 * 33], s[3 * 33]); o.z = cvt_pk_bf16(s[4 * 33], s[5 * 33]); o.w = cvt_pk_bf16(s[6 * 33], s[7 * 33]);
        if (NTS) __builtin_nontemporal_store(o, (u32x4*)(WT + (size_t)(n0 + n) * K + k0 + 8 * c)); else *(u32x4*)(WT + (size_t)(n0 + n) * K + k0 + 8 * c) = o; }
    asm volatile("s_waitcnt lgkmcnt(0)" ::: "memory");
}
template <bool R_DFAST = false, class PF, class RF>
__device__ __forceinline__ void fold_tile(bf16_t* out, int Kout, unsigned char* lds, const PF& P, const RF& R) {
    float* Ps = (float*)lds;
    float* Rt = Ps + 64 * 132;
    bf16_t* Os = (bf16_t*)(Rt + 64 * 132);
    const int t = threadIdx.x;
    __syncthreads();
    { float pv[16], rv[16];
#pragma unroll
      for (int j = 0; j < 16; ++j) { const int i = t + j * NTHREADS; pv[j] = P(i >> 7, i & 127); }
#pragma unroll
      for (int j = 0; j < 16; ++j) { const int i = t + j * NTHREADS; rv[j] = R(R_DFAST ? (i & 127) : (i >> 6), R_DFAST ? (i >> 7) : (i & 63)); }
#pragma unroll
      for (int j = 0; j < 16; ++j) { const int i = t + j * NTHREADS; Ps[(i >> 7) * 132 + (i & 127)] = pv[j]; }
#pragma unroll
      for (int j = 0; j < 16; ++j) { const int i = t + j * NTHREADS; const int d = R_DFAST ? (i & 127) : (i >> 6), nn = R_DFAST ? (i >> 7) : (i & 63); Rt[nn * 132 + d] = rv[j]; } }
    __syncthreads();
    const int nn = t >> 3, kq = t & 7;
    float a[8];
#pragma unroll
    for (int i = 0; i < 8; ++i) a[i] = 0.f;
    for (int d4 = 0; d4 < 32; ++d4) { const f32x4 r = *(const f32x4*)(Rt + nn * 132 + d4 * 4);
#pragma unroll
        for (int i = 0; i < 8; ++i) { const f32x4 p = *(const f32x4*)(Ps + (kq + 8 * i) * 132 + d4 * 4); a[i] += p.x * r.x + p.y * r.y + p.z * r.z + p.w * r.w; } }
#pragma unroll
    for (int i = 0; i < 8; ++i) Os[nn * 72 + kq + 8 * i] = (bf16_t)(cvt_pk_bf16(a[i], 0.f) & 0xffffu);
    __syncthreads();
    *(u32x4*)(out + (size_t)nn * Kout + kq * 8) = *(const u32x4*)(Os + nn * 72 + kq * 8);
}

__device__ __forceinline__ void p0_transposes(const Ctx& C, unsigned char* lds, const int l, const int worker, const int nw) {
    {
        float* scr = (float*)(lds + C.wave * 16384);
        const int gw = worker * NWAVES + C.wave, NGW = nw * NWAVES;
        constexpr int I_IN = (DM / 64) * (NIN / 32), I_QR = (QL / 64) * (NH * 64 / 32), I_OUT = (DM / 64) * (DM / 32), I_GU = (DM / 64) * (NGU / 32), I_DN = (DFF / 64) * (DM / 32);
        constexpr int PER_LAYER = I_IN + I_QR + I_OUT + I_GU + I_DN;
        for (int it = gw; it < PER_LAYER; it += NGW) {
            int r = it;
            bf16_t* W = (bf16_t*)(C.ws + WS_W + (size_t)l * LW_BYTES);
            if (r < I_IN) { const float* w = C.in(7) + (size_t)l * DM * DIN;
                transpose_item(W + W_IN, DM, r, NIN / 32, scr, C.lane, [=](int k, int n) { const float v = __builtin_nontemporal_load(w + (size_t)k * DIN + (n < DIN ? n : DIN - 1)); return n < DIN ? v : 0.f; }, l > 0); continue; } r -= I_IN;
            if (r < I_QR) { const float* w = C.in(9) + (size_t)l * QL * QW; const float* gq = C.in(8) + l * QL;
                const int nblk = NH * 64 / 32, kb = r / nblk, nb = r % nblk, hh = nb >> 1, e0 = (nb & 1) * 32;
                bf16_t* dst = W + W_Q + (size_t)(hh * 192 + 128 + e0 - 32 * nb) * QL;
                transpose_item(dst, QL, kb * nblk + nb, nblk, scr, C.lane, [=](int k, int n) { const int e = n & 63, hd = n >> 6, p = e >> 1, comp = e & 1;
                    return w[(size_t)k * QW + hd * 192 + 128 + (p >> 4) * 32 + comp * 16 + (p & 15)] * gq[k] * C2; }, l > 0); continue; } r -= I_QR;
            if (r < I_OUT) { const float* w = C.in(16) + (size_t)l * DM * DM;
                transpose_item(W + W_OUT, DM, r, DM / 32, scr, C.lane, [=](int k, int n) { return __builtin_nontemporal_load(w + (size_t)k * DM + n); }, l > 0); continue; } r -= I_OUT;
            if (r < I_GU) { const float* wg = C.in(19) + (size_t)l * DM * DFF; const float* wu = C.in(20) + (size_t)l * DM * DFF;
                transpose_item(W + W_GU, DM, r, NGU / 32, scr, C.lane, [=](int k, int n) { const int tile = n >> 8, hf = (n >> 7) & 1, cc = n & 127; return __builtin_nontemporal_load((hf ? wu : wg) + (size_t)k * DFF + tile * 128 + cc); }, l > 0); continue; } r -= I_GU;
            { const float* w = C.in(21) + (size_t)l * DFF * DM;
                transpose_item(W + W_DN, DFF, r, DM / 32, scr, C.lane, [=](int k, int n) { return __builtin_nontemporal_load(w + (size_t)k * DM + n); }, l > 0); }
        }
    }
}
__device__ __forceinline__ void p0_folds(const Ctx& C, unsigned char* lds, const int l, const int worker, const int nw) {
    {
        constexpr int T_Q = NH * 2 * 4, T_O = 16 * 16, T_PC = 16 * 8, PER_LAYER = T_Q + T_O + T_PC;
        for (int it = worker; it < PER_LAYER; it += nw) {
            int r = it;
            bf16_t* W = (bf16_t*)(C.ws + WS_W + (size_t)l * LW_BYTES);
            const float* w_uq = C.in(9) + (size_t)l * QL * QW; const float* w_ukv = C.in(11) + (size_t)l * KVL * 2048; const float* gq = C.in(8) + l * QL;
            if (r < T_Q) { const int hh = r >> 3, jt = (r >> 2) & 1, itile = r & 3;
                fold_tile<true>(W + W_Q + (size_t)(hh * 192 + jt * 64) * QL + itile * 64, QL, lds,
                          [=](int kk, int d) { const int i = itile * 64 + kk; return w_uq[(size_t)i * QW + hh * 192 + d] * gq[i] * C2; },
                          [=](int d, int nn) { return w_ukv[(size_t)(jt * 64 + nn) * 2048 + hh * 256 + d]; });
                continue; } r -= T_Q;
            if (r < T_O) { const int nt = r >> 4, kt = r & 15, hh = kt >> 1, j0 = (kt & 1) * 64; const float* w_o = C.in(12) + (size_t)l * DM * DM;
                fold_tile(W + W_O + (size_t)(nt * 64) * DM + hh * 128 + j0, DM, lds,
                          [=](int kk, int d) { return w_ukv[(size_t)(j0 + kk) * 2048 + hh * 256 + 128 + d]; },
                          [=](int d, int nn) { return w_o[(size_t)(hh * 128 + d) * DM + nt * 64 + nn]; });
                continue; } r -= T_O;
            { const int nt = r >> 3, kt = r & 7, gg = kt >> 1, c0 = (kt & 1) * 64; const float* w_pool = C.in(13) + ((size_t)l * 4 + gg) * 128 * 128; const float* psc = C.in(14) + l * PW + gg * 128;
              const float* w_op = C.in(15) + (size_t)l * PW * DM;
                fold_tile(W + W_PC + (size_t)(nt * 64) * PW + gg * 128 + c0, PW, lds,
                          [=](int kk, int d) { return w_pool[(size_t)(c0 + kk) * 128 + d] * psc[d]; },
                          [=](int d, int nn) { return w_op[(size_t)(gg * 128 + d) * DM + nt * 64 + nn]; }); }
        }
    }
    __syncthreads();
}
__device__ __forceinline__ void p0_mod_tab(const Ctx& C, unsigned char* lds) {
    const float* w_ada = C.in(4); const float* b_ada = C.in(5);
    {
        float* sv = (float*)lds;
        float* red = sv + 5 * DM;
        float* MOD = (float*)(C.ws + WS_MOD);
        const int t = C.tid, ks = t >> 6, cc = t & 63;
        bool have = false;
        for (int it = C.bid; it < DEPTH * (NMOD * DM / 64); it += C.G) {
            const int l = it / (NMOD * DM / 64), n0 = (it % (NMOD * DM / 64)) * 64;
            __syncthreads();
            if (!have) { for (int i = t; i < 5 * DM; i += NTHREADS) { const int s = i / DM, k = i % DM; const float* src = s < 4 ? C.in(1) + s * DM : C.in(3); const float v = src[k]; sv[i] = v / (1.f + __expf(-v)); } have = true; __syncthreads(); }
            float a0 = 0, a1 = 0, a2 = 0, a3 = 0, a4 = 0;
            const float* Wp = w_ada + (size_t)l * DM * (NMOD * DM) + n0 + cc;
#pragma unroll 32
            for (int k = ks * 128; k < ks * 128 + 128; ++k) { const float w = __builtin_nontemporal_load(Wp + (size_t)k * (NMOD * DM)); a0 += sv[k] * w; a1 += sv[DM + k] * w; a2 += sv[2 * DM + k] * w; a3 += sv[3 * DM + k] * w; a4 += sv[4 * DM + k] * w; }
            red[(ks * 5 + 0) * 64 + cc] = a0; red[(ks * 5 + 1) * 64 + cc] = a1; red[(ks * 5 + 2) * 64 + cc] = a2; red[(ks * 5 + 3) * 64 + cc] = a3; red[(ks * 5 + 4) * 64 + cc] = a4;
            __syncthreads();
            if (t < 320) { const int s = t >> 6; float v = b_ada[l * NMOD * DM + n0 + cc];
#pragma unroll
                for (int q = 0; q < 8; ++q) v += red[(q * 5 + s) * 64 + cc];
                MOD[((size_t)l * 5 + s) * NMOD * DM + n0 + cc] = v; }
        }
        __syncthreads();
    }
    if (C.bid == C.G - 1) {
        f32x2* tab = (f32x2*)(C.ws + WS_TAB);
        for (int i = C.tid; i < 64 * 16; i += NTHREADS) { const int pos = i >> 4, f = i & 15; const float inv = powf(10000.f, -(float)(2 * f) / 32.f), ang = (float)pos * inv;
            tab[i] = (f32x2){cosf(ang), sinf(ang)}; }
    }
}

__device__ __forceinline__ void row_pass(const Ctx& C, int row_lo, int row_hi, bool from_input, const bf16_t* Yb, const float* gpost, int kg,
                                         bf16_t* hdst, const float* gpre, const float* mod_res, const float* mod_h, int ksc, int ksh, const bf16_t* slab = nullptr) {
    const int gw = C.bid * NWAVES + C.wave, NGW = C.G * NWAVES, lane = C.lane;
    for (int r = row_lo + gw; r < row_hi; r += NGW) {
        const int slot = mod_slot(r);
        f32x4 x[4], y[4], gp[4], mg[4], gq[4], sc[4], sh[4];
        if (!XS_BF16 || !Yb || from_input) {
            const f32x4* xr = (const f32x4*)((!Yb || from_input) ? xin_row(C, r) : xs_row(C, r)) + lane;
#pragma unroll
            for (int j = 0; j < 4; ++j) x[j] = __builtin_nontemporal_load(xr + 64 * j);
        } else {
            const u32x2* xr = (const u32x2*)xs_row(C, r) + lane;
#pragma unroll
            for (int j = 0; j < 4; ++j) { const u32x2 xx = __builtin_nontemporal_load(xr + 64 * j); x[j] = (f32x4){bflo(xx.x), bfhi(xx.x), bflo(xx.y), bfhi(xx.y)}; }
        }
        if (Yb) {
            const u32x2* yr = (const u32x2*)(Yb + (size_t)r * DM) + lane;
            if (slab && r < NCTX) {
#pragma unroll
                for (int j = 0; j < 4; ++j) { y[j] = (f32x4){0.f, 0.f, 0.f, 0.f};
                    for (int ks = 0; ks < NSD; ++ks) { const u32x2 yy = ((const u32x2*)(slab + ((size_t)ks * NCTX + r) * DM))[lane + 64 * j]; y[j] += (f32x4){bflo(yy.x), bfhi(yy.x), bflo(yy.y), bfhi(yy.y)}; } }
            } else {
#pragma unroll
                for (int j = 0; j < 4; ++j) { const u32x2 yy = __builtin_nontemporal_load(yr + 64 * j); y[j] = (f32x4){bflo(yy.x), bfhi(yy.x), bflo(yy.y), bfhi(yy.y)}; }
            }
            const float* mgp = mod_res + (size_t)slot * NMOD * DM + kg * DM;
#pragma unroll
            for (int j = 0; j < 4; ++j) { gp[j] = ((const f32x4*)gpost)[lane + 64 * j]; mg[j] = ((const f32x4*)mgp)[lane + 64 * j]; }
        }
        if (hdst) {
            const float* msc = mod_h + (size_t)slot * NMOD * DM + ksc * DM; const float* msh = mod_h + (size_t)slot * NMOD * DM + ksh * DM;
#pragma unroll
            for (int j = 0; j < 4; ++j) { gq[j] = ((const f32x4*)gpre)[lane + 64 * j]; sc[j] = ((const f32x4*)msc)[lane + 64 * j]; sh[j] = ((const f32x4*)msh)[lane + 64 * j]; }
        }
        if (Yb) {
            float ss = 0.f;
#pragma unroll
            for (int j = 0; j < 4; ++j) ss += y[j].x * y[j].x + y[j].y * y[j].y + y[j].z * y[j].z + y[j].w * y[j].w;
            const float rstd = rsqrtf(wave_sum(ss) * (1.f / DM) + EPS);
            float* xp = xs_row(C, r);
#pragma unroll
            for (int j = 0; j < 4; ++j) { x[j] = x[j] + mg[j] * (y[j] * rstd * gp[j]);
                if (!XS_BF16 || !hdst) __builtin_nontemporal_store(x[j], (f32x4*)xp + lane + 64 * j);
                else { u32x2 w; w.x = cvt_pk_bf16(x[j].x, x[j].y); w.y = cvt_pk_bf16(x[j].z, x[j].w); __builtin_nontemporal_store(w, (u32x2*)xp + lane + 64 * j); } }
        }
        if (hdst) {
            float ss = 0.f;
#pragma unroll
            for (int j = 0; j < 4; ++j) ss += x[j].x * x[j].x + x[j].y * x[j].y + x[j].z * x[j].z + x[j].w * x[j].w;
            const float rstd = rsqrtf(wave_sum(ss) * (1.f / DM) + EPS);
            u32x2* hp = (u32x2*)(hdst + (size_t)r * DM) + lane;
#pragma unroll
            for (int j = 0; j < 4; ++j) { const f32x4 hv = x[j] * rstd * gq[j] * (sc[j] + 1.f) + sh[j]; u32x2 w; w.x = cvt_pk_bf16(hv.x, hv.y); w.y = cvt_pk_bf16(hv.z, hv.w); hp[64 * j] = w; }
        }
    }
}

template <int HW>
__device__ __forceinline__ void pool_strip(const bf16_t* ZA, bf16_t* D, int r0, int seq_lo, int seq_hi, int c) {
    float ps[33]; ps[0] = 0.f;
    float v8[16];
    unsigned short raw[32];
#pragma unroll
    for (int i = 0; i < 32; ++i) { int r = r0 - 8 + i; r = r < seq_lo ? seq_lo : (r >= seq_hi ? seq_hi - 1 : r); raw[i] = ZA[(size_t)r * ZAW + OFF_POOL + c]; }
#pragma unroll
    for (int i = 0; i < 32; ++i) { const int r = r0 - 8 + i; const float v = (r >= seq_lo && r < seq_hi) ? bf2f(raw[i]) : 0.f; ps[i + 1] = ps[i] + v; if (i >= 8 && i < 24) v8[i - 8] = v; }
#pragma unroll
    for (int j = 0; j < 16; ++j) { const int pos = r0 + j; int lo = pos - HW; if (lo < seq_lo) lo = seq_lo; int hi = pos + HW; if (hi > seq_hi) hi = seq_hi;
        const float mean = (ps[j + 8 + HW] - ps[j + 8 - HW]) * __builtin_amdgcn_rcpf((float)(hi - lo));
        D[(size_t)pos * PW + c] = (bf16_t)(cvt_pk_bf16(mean - v8[j], 0.f) & 0xffffu); }
}
__device__ __forceinline__ void p3a_rowops(const Ctx& C, int l) {
    const bf16_t* ZA = (const bf16_t*)(C.ws + AR_ZA); bf16_t* KL = (bf16_t*)(C.ws + AR_KL); bf16_t* D = (bf16_t*)(C.ws + AR_D);
    float* RSTDQ = (float*)(C.ws + WS_RSTDQ); const f32x2* tab = (const f32x2*)(C.ws + WS_TAB); const float* gkv = C.in(10) + l * KVL;
    const int gw = C.bid * NWAVES + C.wave, NGW = C.G * NWAVES, lane = C.lane, sub = lane >> 4, l16 = lane & 15;
    const float* SLZ = (const float*)(C.ws + WS_SLZ);
    for (int rb = gw * 4; rb < MROWS; rb += NGW * 4) {
        const int r = rb + sub;
        float kv[8], x1a, x1b, x2a, x2b;
        const int p = 2 * l16, axis = p >> 4, f = p & 15;
        if (l > 0 && r < NCTX) {
#pragma unroll
            for (int i = 0; i < 8; ++i) kv[i] = 0.f;
            x1a = x1b = x2a = x2b = 0.f;
#pragma unroll
            for (int ks = 0; ks < 4; ++ks) { const float* sl = SLZ + ((size_t)ks * NCTX + r) * 256; const f32x4 a0 = ((const f32x4*)sl)[2 * l16], a1 = ((const f32x4*)sl)[2 * l16 + 1];
                kv[0] += a0.x; kv[1] += a0.y; kv[2] += a0.z; kv[3] += a0.w; kv[4] += a1.x; kv[5] += a1.y; kv[6] += a1.z; kv[7] += a1.w;
                const f32x2 u1 = *(const f32x2*)(sl + 128 + axis * 32 + f), u2 = *(const f32x2*)(sl + 128 + axis * 32 + 16 + f); x1a += u1.x; x1b += u1.y; x2a += u2.x; x2b += u2.y; }
        } else {
            const bf16_t* z = ZA + (size_t)r * ZAW;
            const u32x4 q0 = ((const u32x4*)z)[2 * l16], q1 = ((const u32x4*)z)[2 * l16 + 1];
            float ss = 0.f;
            { float t; t = bflo(q0.x); ss += t * t; t = bfhi(q0.x); ss += t * t; t = bflo(q0.y); ss += t * t; t = bfhi(q0.y); ss += t * t; t = bflo(q0.z); ss += t * t; t = bfhi(q0.z); ss += t * t; t = bflo(q0.w); ss += t * t; t = bfhi(q0.w); ss += t * t;
              t = bflo(q1.x); ss += t * t; t = bfhi(q1.x); ss += t * t; t = bflo(q1.y); ss += t * t; t = bfhi(q1.y); ss += t * t; t = bflo(q1.z); ss += t * t; t = bfhi(q1.z); ss += t * t; t = bflo(q1.w); ss += t * t; t = bfhi(q1.w); ss += t * t; }
            ss += __shfl_xor(ss, 1); ss += __shfl_xor(ss, 2); ss += __shfl_xor(ss, 4); ss += __shfl_xor(ss, 8);
            if (l16 == 0) RSTDQ[r] = rsqrtf(ss * (1.f / QL) + EPS);
            const u32x4 zk = ((const u32x4*)(z + OFF_KV))[l16];
            kv[0] = bflo(zk.x); kv[1] = bfhi(zk.x); kv[2] = bflo(zk.y); kv[3] = bfhi(zk.y); kv[4] = bflo(zk.z); kv[5] = bfhi(zk.z); kv[6] = bflo(zk.w); kv[7] = bfhi(zk.w);
            const unsigned u1 = *(const unsigned*)(z + OFF_KR + axis * 32 + f), u2 = *(const unsigned*)(z + OFF_KR + axis * 32 + 16 + f);
            x1a = bflo(u1); x1b = bfhi(u1); x2a = bflo(u2); x2b = bfhi(u2);
        }
        float sk = 0.f;
#pragma unroll
        for (int i = 0; i < 8; ++i) sk += kv[i] * kv[i];
        sk += __shfl_xor(sk, 1); sk += __shfl_xor(sk, 2); sk += __shfl_xor(sk, 4); sk += __shfl_xor(sk, 8);
        const float rk = rsqrtf(sk * (1.f / KVL) + EPS);
        bf16_t* kl = KL + (size_t)key_index(r) * KW;
        const f32x4 g0 = ((const f32x4*)gkv)[2 * l16], g1 = ((const f32x4*)gkv)[2 * l16 + 1];
        u32x4 w; w.x = cvt_pk_bf16(kv[0] * rk * g0.x, kv[1] * rk * g0.y); w.y = cvt_pk_bf16(kv[2] * rk * g0.z, kv[3] * rk * g0.w); w.z = cvt_pk_bf16(kv[4] * rk * g1.x, kv[5] * rk * g1.y); w.w = cvt_pk_bf16(kv[6] * rk * g1.z, kv[7] * rk * g1.w);
        ((u32x4*)kl)[l16] = w;
        if (r >= NCTX) { const int tpos = (r - NCTX) & (SEQ - 1); const f32x2* tb = tab + (axis ? (tpos & 63) : (tpos >> 6)) * 16 + f; const f32x2 ca = tb[0], cb = tb[1];
            float a_, b_; a_ = x1a; b_ = x2a; x1a = a_ * ca.x - b_ * ca.y; x2a = a_ * ca.y + b_ * ca.x; a_ = x1b; b_ = x2b; x1b = a_ * cb.x - b_ * cb.y; x2b = a_ * cb.y + b_ * cb.x; }
        u32x2 wr_; wr_.x = cvt_pk_bf16(x1a, x2a); wr_.y = cvt_pk_bf16(x1b, x2b);
        ((u32x2*)(kl + 128))[l16] = wr_;
    }
    const int c = C.tid, gsel = c >> 7;
    for (int s = (l > 0 ? NCTX / 16 : 0) + C.bid; s < MROWS / 16; s += C.G) {
        const int r0 = s * 16; int seq_lo, seq_hi;
        if (r0 < NCTX) { seq_lo = (r0 / CTX) * CTX; seq_hi = seq_lo + CTX; } else { seq_lo = NCTX + ((r0 - NCTX) / SEQ) * SEQ; seq_hi = seq_lo + SEQ; }
        if (gsel == 0) pool_strip<1>(ZA, D, r0, seq_lo, seq_hi, c);
        else if (gsel == 1) pool_strip<2>(ZA, D, r0, seq_lo, seq_hi, c);
        else if (gsel == 2) pool_strip<4>(ZA, D, r0, seq_lo, seq_hi, c);
        else pool_strip<8>(ZA, D, r0, seq_lo, seq_hi, c);
    }
}

template <int ABL = 0> __device__ __forceinline__ void attn_phase(const Ctx& C, unsigned char* lds, int l) {
    const bf16_t* Q = (const bf16_t*)(C.ws + AR_Q); const bf16_t* KL = (const bf16_t*)(C.ws + AR_KL); bf16_t* O = (bf16_t*)(C.ws + AR_O);
    const float* rstdq = (const float*)(C.ws + WS_RSTDQ); const f32x2* tab = (const f32x2*)(C.ws + WS_TAB);
    const int nlat = NB * NH * (SEQ / 256), nctx = (l == 0) ? NB * NH : 0;
    for (int uid = C.bid; uid < nlat; uid += C.G) { const int b = uid / (NH * 16), h = (uid / 16) % NH, qt = uid % 16;
#if USE_MFMA_ATTN
        if (USE_ATTN2) { if (ATTN2_GSEL == 0 ? C.wave < 4 : ATTN2_GSEL == 1 ? (C.wave & 1) == 0 : (C.wave & 2) == 0) attn2::unit<true, ABL>((char*)lds, Q, KL + (size_t)b * KPB * KW, O, rstdq, tab, NCTX + b * SEQ + qt * 256, h, KPB); else attn2::unit<false, ABL>((char*)lds, Q, KL + (size_t)b * KPB * KW, O, rstdq, tab, NCTX + b * SEQ + qt * 256, h, KPB); }
        else attn::unit<ABL>((char*)lds, Q, KL + (size_t)b * KPB * KW, O, rstdq, tab, NCTX + b * SEQ + qt * 256, h, KPB);
#else
        attn_simple_unit(lds, Q, KL, O, rstdq, tab, NCTX + b * SEQ + qt * 256, h, b * KPB, KPB);
#endif
    }
    for (int v = C.G - 1 - C.bid; v < nctx; v += C.G) { const int b = v / NH, h = v % NH;
#if USE_MFMA_ATTN
        if (USE_ATTN2) { if (ATTN2_GSEL == 0 ? C.wave < 4 : ATTN2_GSEL == 1 ? (C.wave & 1) == 0 : (C.wave & 2) == 0) attn2::unit<true, ABL>((char*)lds, Q, KL + (size_t)b * KPB * KW, O, rstdq, tab, b * CTX, h, CTX); else attn2::unit<false, ABL>((char*)lds, Q, KL + (size_t)b * KPB * KW, O, rstdq, tab, b * CTX, h, CTX); }
        else attn::unit<ABL>((char*)lds, Q, KL + (size_t)b * KPB * KW, O, rstdq, tab, b * CTX, h, CTX);
#else
        attn_simple_unit(lds, Q, KL, O, rstdq, tab, b * CTX, h, b * KPB, CTX);
#endif
    }
}

#define GAS __attribute__((address_space(1)))
#define LAS __attribute__((address_space(3)))
#define XB_TMO      128
#define XB_XCNT(j)  (256  + 64 * (j))
#define XB_XSUB(j)  (1280 + 64 * (j))
#define XB_XGEN(j)  (2304 + 64 * (j))
#define XB_TOP      3328
#define XB_TOPGEN   3392
#define XCD_BAR_WORDS 3456
#define XB_SPIN_CAP (1u << 18)

__device__ __forceinline__ unsigned xb_ld(unsigned* p)              { return __hip_atomic_load(p, __ATOMIC_RELAXED, __HIP_MEMORY_SCOPE_AGENT); }
__device__ __forceinline__ unsigned xb_add(unsigned* p, unsigned v) { return __hip_atomic_fetch_add(p, v, __ATOMIC_RELAXED, __HIP_MEMORY_SCOPE_AGENT); }
__device__ __forceinline__ unsigned xb_xcc_id() { return (unsigned)__builtin_amdgcn_s_getreg((3 << 11) | 20) & 0xFu; }
#define XB_SPIN(cond, bar) do { unsigned _sp = 0; while (cond) { __builtin_amdgcn_s_sleep(1); \
    if ((++_sp & 255u) == 0u) { if (xb_ld(&(bar)[XB_TMO])) break; if (_sp > XB_SPIN_CAP) { atomicAdd(&(bar)[XB_TMO], 1u); break; } } } } while (0)

struct XcdBarrier {
    unsigned* bar; unsigned x;
    volatile LAS unsigned* st;
};

__device__ __forceinline__ XcdBarrier xcd_barrier_post(unsigned* bar, volatile LAS unsigned* st) {
    XcdBarrier b; b.bar = bar; b.x = xb_xcc_id(); b.st = st;
    if (threadIdx.x == 0) (void)xb_add(&bar[XB_XCNT(b.x)], 1u);
    return b;
}
__device__ __forceinline__ void xcd_barrier_complete(unsigned* bar, unsigned x, unsigned& nloc, unsigned& nx) {
    const unsigned G = gridDim.x * gridDim.y * gridDim.z;
    unsigned sum, cnt, mine, sp = 0u;
    for (;;) {
        sum = 0u; cnt = 0u; mine = 0u;
#pragma unroll
        for (unsigned j = 0; j < 16; ++j) { const unsigned c = xb_ld(&bar[XB_XCNT(j)]); sum += c; cnt += (c > 0u) ? 1u : 0u; mine = (j == x) ? c : mine; }
        if (sum == G) break;
        __builtin_amdgcn_s_sleep(1);
        if ((++sp & 255u) == 0u) { if (xb_ld(&bar[XB_TMO])) break; if (sp > XB_SPIN_CAP) { atomicAdd(&bar[XB_TMO], 1u); break; } }
    }
    nloc = mine > 0u ? mine : 1u; nx = cnt > 0u ? cnt : 1u;
}

__device__ __forceinline__ void xcd_barrier(const XcdBarrier& b) {
    asm volatile("s_waitcnt vmcnt(0)" ::: "memory");
    __syncthreads();
    if (threadIdx.x == 0) {
        unsigned* bar = b.bar;
        __builtin_amdgcn_s_waitcnt(0);
        unsigned nloc = b.st[0], nx = b.st[1];
        if (nloc == 0u) { xcd_barrier_complete(bar, b.x, nloc, nx); b.st[0] = nloc; b.st[1] = nx; }
        const unsigned old = xb_add(&bar[XB_XSUB(b.x)], 1u);
        const unsigned gen = old / nloc;
        if (old + 1u == (gen + 1u) * nloc) {
            __builtin_amdgcn_fence(__ATOMIC_RELEASE, "agent");
            asm volatile("s_waitcnt vmcnt(0)" ::: "memory");
            const unsigned og = xb_add(&bar[XB_TOP], 1u);
            const unsigned tg = og / nx;
            if (og + 1u == (tg + 1u) * nx) xb_add(&bar[XB_TOPGEN], 1u);
            else XB_SPIN(xb_ld(&bar[XB_TOPGEN]) == tg, bar);
            __builtin_amdgcn_fence(__ATOMIC_ACQUIRE, "agent");
            xb_add(&bar[XB_XGEN(b.x)], 1u);
            asm volatile("s_waitcnt vmcnt(0)" ::: "memory");
        } else {
            XB_SPIN(xb_ld(&bar[XB_XGEN(b.x)]) == gen, bar);
            __builtin_amdgcn_fence(__ATOMIC_ACQUIRE, "agent");
            asm volatile("s_waitcnt vmcnt(0)" ::: "memory");
        }
    }
    __syncthreads();
}

#define RUN(k) (ph_lo <= (k) && (k) < ph_hi)
#define SEAM() do { if (RUN(phase) && RUN(phase + 1)) { if (USE_CG_FIRST == 1 && phase == 0) grid.sync(); else xcd_barrier(bar); } ++phase; asm volatile("" : "+s"(C.ws), "+s"(C.out), "+s"(C.bid), "+s"(C.G)); ws = C.ws; } while (0)
#define MOD ((float*)(ws + WS_MOD))
#define W ((const bf16_t*)(ws + WS_W + (size_t)l * LW_BYTES))
#define modl (MOD + (size_t)l * 5 * NMOD * DM)
template <int l>
__device__ __forceinline__ void run_layer(Ctx& C, unsigned char* lds, cg::grid_group& grid, const XcdBarrier& bar, int& phase, const int ph_lo, const int ph_hi) {
    gws_t ws = C.ws;
        const bool last = (l == DEPTH - 1);
        constexpr int TM0 = (l == 0) ? 0 : NCTX / BM, TMN = MROWS / BM - TM0;
        constexpr int ROW0 = TM0 * BM;
        if (RUN(phase)) {
            { Gemm<DM, DM, DM> g{(const bf16_t*)(ws + AR_H), W + W_IN}; StaticOrder S; S.init(TMN, NIN / BM, C.G, C.bid, TM0);
              EpiZ E{(bf16_t*)(ws + AR_ZA), (bf16_t*)(ws + AR_G0), (bf16_t*)(ws + AR_G1)}; if (GEMM_ON(0)) gemm_phase_any(lds, g, S, E); if (DUP(3)) gemm_phase_any(lds, g, S, E); }
            if (l > 0) {
              Gemm<DM, DM, 256> g{(const bf16_t*)(ws + AR_H), W + W_IN}; SplitOrder S; S.init(NCTX / BM, 1, 4, 256, C.G, (C.bid + 128) % C.G, 0, 1);
              EpiSlab<256, NCTX, true> E{(void*)(ws + WS_SLZ), 256}; gemm_phase_any(lds, g, S, E); }
        }
        SEAM();
        if (RUN(phase)) {
            { Gemm<ZAW, QL, QL> g{(const bf16_t*)(ws + AR_ZA), W + W_Q}; StaticOrder S; S.init(TMN, QW / BM, C.G, C.bid, TM0);
              EpiN<0, QW> E{(bf16_t*)(ws + AR_Q), nullptr, nullptr}; if (GEMM_ON(1)) gemm_phase_any(lds, g, S, E); }
            p3a_rowops(C, l); if (DUP(2)) p3a_rowops(C, l);
        }
        SEAM();
        if (RUN(phase)) {
            { Gemm<PW, PW, PW> g{(const bf16_t*)(ws + AR_D), W + W_PC}; StaticOrder S; S.init(TMN, DM / BM, C.G, C.bid, TM0);
              EpiN<1> E{(bf16_t*)(ws + AR_G1), nullptr, nullptr}; if (GEMM_ON(2)) gemm_phase_any(lds, g, S, E); }
            if (DUP(1)) attn_phase<ATTN_ABL>(C, lds, l); attn_phase(C, lds, l);
        }
        SEAM();
        if (RUN(phase)) { Gemm<DM, DM, DM> g{(const bf16_t*)(ws + AR_O), W + W_O}; StaticOrder S; S.init(TMN, DM / BM, C.G, C.bid, TM0);
            EpiN<2> E{(bf16_t*)(ws + AR_MG), (const bf16_t*)(ws + AR_G0), (const bf16_t*)(ws + AR_G1)}; if (GEMM_ON(3)) gemm_phase_any(lds, g, S, E); if (DUP(6)) gemm_phase_any(lds, g, S, E);
            if (l == 0 && DEPTH > 1 && C.bid >= LZY0) p0_transposes(C, lds, 1, C.bid - LZY0, C.G - LZY0); }
        SEAM();
        if (RUN(phase)) { Gemm<DM, DM, DM> g{(const bf16_t*)(ws + AR_MG), W + W_OUT}; StaticOrder S; S.init(TMN, DM / BM, C.G, C.bid, TM0);
            EpiN<0> E{(bf16_t*)(ws + AR_Y), nullptr, nullptr}; if (GEMM_ON(4)) gemm_phase_any(lds, g, S, E);
            if (l == 0 && DEPTH > 1 && C.bid >= LZY0) p0_folds(C, lds, 1, C.bid - LZY0, C.G - LZY0); }
        SEAM();
        if (RUN(phase)) row_pass(C, ROW0, MROWS, l == 0, (const bf16_t*)(ws + AR_Y), C.in(17) + l * DM, 2, (bf16_t*)(ws + AR_HF), C.in(18) + l * DM, modl, modl, 3, 4);
        SEAM();
        if (RUN(phase)) { Gemm<DM, DM, DM> g{(const bf16_t*)(ws + AR_HF), W + W_GU}; StaticOrder S; S.init(TMN, NGU / BM, C.G, C.bid, TM0);
            EpiGU E{(bf16_t*)(ws + AR_ACT)}; if (GEMM_ON(5)) gemm_phase_any(lds, g, S, E); if (DUP(4)) gemm_phase_any(lds, g, S, E); }
        SEAM();
        if (RUN(phase)) {
            { Gemm<DFF, DFF, DFF> g{(const bf16_t*)(ws + AR_ACT), W + W_DN}; StaticOrder S; S.init(MROWS / BM - NCTX / BM, DM / BM, C.G, C.bid, NCTX / BM);
              EpiN<0> E{(bf16_t*)(ws + AR_F), nullptr, nullptr}; if (GEMM_ON(6)) gemm_phase_any(lds, g, S, E); if (DUP(5)) gemm_phase_any(lds, g, S, E); }
            if (l == 0) {
              Gemm<DFF, DFF, 256> g{(const bf16_t*)(ws + AR_ACT), W + W_DN}; SplitOrder S; S.init(NCTX / BM, DM / BM, NSD, 256, C.G, C.bid, 0, 0);
              EpiSlab<DM, NCTX, false> E{(void*)(ws + AR_SLD), 0}; gemm_phase_any(lds, g, S, E); }
        }
        SEAM();
        if (RUN(phase)) row_pass(C, ROW0, MROWS, false, (const bf16_t*)(ws + AR_F), C.in(22) + l * DM, 5, last ? nullptr : (bf16_t*)(ws + AR_H),
                                 last ? nullptr : C.in(6) + (l + 1) * DM, modl, last ? nullptr : modl + 5 * NMOD * DM, 0, 1, l == 0 ? (const bf16_t*)(ws + AR_SLD) : nullptr);
        if (!last) SEAM();
}

__global__ void __launch_bounds__(NTHREADS, 2) mega_fwd(Args a) {
    extern __shared__ __attribute__((aligned(16))) unsigned char lds[];
    cg::grid_group grid = cg::this_grid();
    const int tid_ = threadIdx.x;
    Ctx C{(gout_t)a.out, (gws_t)a.ws, tid_, tid_ & 63, __builtin_amdgcn_readfirstlane(tid_ >> 6), (int)gridDim.x, (int)blockIdx.x};
    gws_t ws = C.ws;
    int phase = 0;
    const int ph_lo = a.ph_lo, ph_hi = a.ph_hi;
    if (USE_CG_FIRST == 2 && ph_lo > ph_hi) grid.sync();
    volatile LAS unsigned* bst = (volatile LAS unsigned*)((LAS unsigned char*)lds + LDS_BYTES - 64);
    if (tid_ < 2) bst[tid_] = 0u;
    __syncthreads();
    const XcdBarrier bar = xcd_barrier_post((unsigned*)(C.ws + WS_CTL) + 4096, bst);

#ifndef DIS_P0
    if (RUN(phase)) { p0_transposes(C, lds, 0, C.bid, C.G); p0_folds(C, lds, 0, C.bid, C.G); p0_mod_tab(C, lds); }
#endif
    SEAM();
    if (RUN(phase)) { row_pass(C, 0, MROWS, true, nullptr, nullptr, 0, (bf16_t*)(ws + AR_H), C.in(6), nullptr, MOD, 0, 1); if (DUP(7)) row_pass(C, 0, MROWS, true, nullptr, nullptr, 0, (bf16_t*)(ws + AR_H), C.in(6), nullptr, MOD, 0, 1); }
    SEAM();
    run_layer<0>(C, lds, grid, bar, phase, ph_lo, ph_hi);
    run_layer<1>(C, lds, grid, bar, phase, ph_lo, ph_hi);
}

constexpr int N_PHASES = 2 + 9 * DEPTH;

extern "C" void kernel_launch(void* const* d_in, const int* in_sizes, int n_in, void* d_out, int out_size, void* d_ws, size_t ws_size, hipStream_t stream) {
    static int grid = 0;
    if (grid == 0) {
        if (n_in != 23 || out_size != NB * SEQ * DM || ws_size < WS_END) { fprintf(stderr, "kernel_launch: unexpected shapes (n_in %d out %d ws %zu need %zu)\n", n_in, out_size, ws_size, (size_t)WS_END); grid = -1; return; }
        int dev = 0, cus = 0, per_cu = 0;
        (void)hipGetDevice(&dev); (void)hipDeviceGetAttribute(&cus, hipDeviceAttributeMultiprocessorCount, dev);
        if (hipFuncSetAttribute((const void*)mega_fwd, hipFuncAttributeMaxDynamicSharedMemorySize, LDS_BYTES) != hipSuccess) { fprintf(stderr, "kernel_launch: hipFuncSetAttribute failed\n"); grid = -1; return; }
        if (hipOccupancyMaxActiveBlocksPerMultiprocessor(&per_cu, (const void*)mega_fwd, NTHREADS, LDS_BYTES) != hipSuccess || per_cu < 1) { fprintf(stderr, "kernel_launch: occupancy query says %d\n", per_cu); per_cu = 1; }
        (void)hipGetLastError();
        grid = cus;
        fprintf(stderr, "kernel_launch: grid %d (cus %d, per_cu %d), ws %zu\n", grid, cus, per_cu, ws_size);
    }
    if (grid < 0) return;
    (void)hipMemsetAsync((char*)d_ws + WS_CTL, 0, 64 * 1024, stream);
    Args a{};
    for (int i = 0; i < 23; ++i) a.in[i] = (const float*)d_in[i];
    a.out = (float*)d_out; a.ws = (unsigned char*)d_ws; a.ph_lo = 0; a.ph_hi = N_PHASES;
    void* args[] = {&a};
    hipError_t e = hipLaunchCooperativeKernel((const void*)mega_fwd, dim3(grid), dim3(NTHREADS), args, LDS_BYTES, stream);
    if (e != hipSuccess) fprintf(stderr, "kernel_launch: cooperative launch failed: %s (grid %d)\n", hipGetErrorString(e), grid);
}
```

```cpp
#include <hip/hip_runtime.h>
#include <hip/hip_cooperative_groups.h>
#include <cstdio>
#include <cstdint>
namespace cg = cooperative_groups;

#ifndef USE_MFMA_GEMM
#define USE_MFMA_GEMM 1
#endif
#ifndef GEMM_MASK
#define GEMM_MASK 0xff
#endif
#define GEMM_ON(k) ((GEMM_MASK >> (k)) & 1)
#ifndef PROBE_DUP
#define PROBE_DUP 0
#endif
#define DUP(k) ((PROBE_DUP >> (k)) & 1)
#ifndef ATTN_ABL
#define ATTN_ABL 0
#endif
#ifndef GEMM_ALIGN
#define GEMM_ALIGN true
#endif
#ifndef GEMM_SP2
#define GEMM_SP2 true
#endif
#ifndef USE_ATTN2
#define USE_ATTN2 1
#endif
#ifndef NATIVE_PV
#define NATIVE_PV 1
#endif
#ifndef ATTN2_DMA
#define ATTN2_DMA 1
#endif
#ifndef ATTN2_MSEG
#define ATTN2_MSEG 1
#endif
#ifndef XS_BF16
#define XS_BF16 1
#endif
#ifndef SM_NEGM
#define SM_NEGM 1
#endif
#ifndef POOL2
#define POOL2 1
#endif
#ifndef ATTN2_PM
#define ATTN2_PM 0
#endif
#ifndef ATTN2_PV
#define ATTN2_PV 0
#endif
#ifndef ATTN2_GSEL
#define ATTN2_GSEL 0
#endif
#ifndef USE_CG_FIRST
#define USE_CG_FIRST 2
#endif
#ifndef USE_MFMA_ATTN
#define USE_MFMA_ATTN 1
#endif

constexpr int DM = 1024, NB = 4, SEQ = 4096, DEPTH = 2, CTX = 256, NH = 8;
constexpr int QL = 256, KVL = 128, ROPE = 64, PW = 512, DFF = 2816, DIN = 3008, NMOD = 6;
constexpr int OFF_KV = 256, OFF_KR = 384, OFF_POOL = 448, OFF_GATE = 960;
constexpr int NCTX = NB * CTX;
constexpr int MROWS = NCTX + NB * SEQ;
constexpr int ZAW = 960, QW = NH * 192, KW = 192, NIN = 3072, NGU = 2 * DFF;
constexpr int KPB = CTX + SEQ;
constexpr float EPS = 1e-6f;
constexpr float C2 = 0.07216878364870322f * 1.4426950408889634f;
constexpr int NTHREADS = 512, NWAVES = 8;
constexpr int LZY0 = (MROWS / 256) * (DM / 256) - 256;
constexpr int LDS_BYTES = 147456;

typedef unsigned short bf16_t;
typedef short bf16x8 __attribute__((ext_vector_type(8)));
typedef float f32x4 __attribute__((ext_vector_type(4)));
typedef float f32x2 __attribute__((ext_vector_type(2)));
typedef float f32x16 __attribute__((ext_vector_type(16)));
typedef unsigned u32x4 __attribute__((ext_vector_type(4)));
typedef unsigned u32x2 __attribute__((ext_vector_type(2)));

constexpr size_t MiB = 1u << 20;
constexpr size_t WS_CTL = 0;
constexpr size_t WS_MOD = 1 * MiB;
constexpr size_t WS_TAB = WS_MOD + 256 * 1024;
constexpr size_t WS_RSTDQ = WS_TAB + 16 * 1024;
constexpr size_t WS_XC = 2 * MiB;
constexpr size_t WS_W = 6 * MiB;
constexpr size_t W_IN = 0, W_Q = W_IN + (size_t)NIN * DM, W_O = W_Q + (size_t)QW * QL, W_PC = W_O + (size_t)DM * DM, W_OUT = W_PC + (size_t)DM * PW,
                 W_GU = W_OUT + (size_t)DM * DM, W_DN = W_GU + (size_t)NGU * DM, W_END = W_DN + (size_t)DM * DFF;
constexpr size_t LW_BYTES = W_END * 2;
constexpr size_t WS_AR = WS_W + 2 * LW_BYTES + (MiB - (2 * LW_BYTES) % MiB) % MiB;
constexpr size_t AR_G0 = WS_AR, AR_Y = AR_G0, AR_F = AR_G0;
constexpr size_t AR_G1 = WS_AR + 34 * MiB, AR_HF = AR_G1;
constexpr size_t AR_Q = WS_AR + 68 * MiB, AR_H = AR_Q, AR_MG = AR_Q, AR_ACT = AR_Q;
constexpr size_t AR_ZA = WS_AR + 119 * MiB, AR_O = AR_ZA;
constexpr size_t AR_D = WS_AR + 151 * MiB;
constexpr size_t AR_KL = WS_AR + 168 * MiB;
constexpr size_t WS_SLZ = WS_AR + 175 * MiB;
constexpr size_t AR_SLD = AR_G1;
constexpr int NSD = DFF / 256;
constexpr size_t WS_END = WS_SLZ + 4 * MiB;
static_assert(WS_END <= 256 * MiB, "workspace map exceeds 256 MiB");
static_assert((size_t)MROWS * ZAW * 2 <= 32 * MiB && (size_t)MROWS * DFF * 2 <= 100 * MiB - 6 * MiB, "arena");

__device__ __forceinline__ unsigned cvt_pk_bf16(float lo, float hi) { unsigned r; asm volatile("v_cvt_pk_bf16_f32 %0, %1, %2" : "=v"(r) : "v"(lo), "v"(hi)); return r; }
__device__ __forceinline__ float bf2f(unsigned short u) { return __uint_as_float((unsigned)u << 16); }
__device__ __forceinline__ float bflo(unsigned u) { return __uint_as_float(u << 16); }
__device__ __forceinline__ float bfhi(unsigned u) { return __uint_as_float(u & 0xffff0000u); }
__device__ __forceinline__ float wave_sum(float v) {
#pragma unroll
    for (int o = 1; o < 64; o <<= 1) v += __shfl_xor(v, o);
    return v;
}
__device__ __forceinline__ float sigmoidf_(float x) { return __builtin_amdgcn_rcpf(1.f + __builtin_amdgcn_exp2f(x * -1.4426950408889634f)); }

#ifndef USE_WT_STORES
#define USE_WT_STORES 1
#endif
__device__ __forceinline__ void st16(void* p, u32x4 v) {
#if USE_WT_STORES
    asm volatile("global_store_dwordx4 %0, %1, off sc1\n\ts_nop 1" :: "v"((__attribute__((address_space(1))) void*)p), "v"(v) : "memory");
#else
    *(u32x4*)p = v;
#endif
}
struct Args { const float* in[23]; float* out; unsigned char* ws; int ph_lo, ph_hi; };
typedef const __attribute__((address_space(4))) Args* KArgs;
__device__ __forceinline__ KArgs kargs() { KArgs p = (KArgs)__builtin_amdgcn_kernarg_segment_ptr(); asm volatile("" : "+s"(p)); return p; }
typedef __attribute__((address_space(1))) unsigned char* gws_t;
typedef __attribute__((address_space(1))) float* gout_t;
struct Ctx {
    gout_t out; gws_t ws;
    int tid, lane, wave, G, bid;
    __device__ __forceinline__ const float* in(int i) const { return kargs()->in[i]; }
};
__device__ __forceinline__ float* xs_row(const Ctx& C, int r) { return r < NCTX ? (float*)(C.ws + WS_XC) + (size_t)r * DM : (float*)(C.out + (size_t)(r - NCTX) * DM); }
__device__ __forceinline__ const float* xin_row(const Ctx& C, int r) { return r < NCTX ? C.in(2) + (size_t)r * DM : C.in(0) + (size_t)(r - NCTX) * DM; }
__device__ __forceinline__ int mod_slot(int r) { return r < NCTX ? 4 : (r - NCTX) / SEQ; }
__device__ __forceinline__ int key_index(int r) { return r < NCTX ? (r / CTX) * KPB + (r % CTX) : ((r - NCTX) / SEQ) * KPB + CTX + (r - NCTX) % SEQ; }

constexpr int BM = 256, NXCD = 8, WGM = 8;
struct Unit { int pm, pn, koff, ks; };
template <int LDA, int LDB, int KK> struct Gemm { const bf16_t* A; const bf16_t* Bt; static constexpr int lda = LDA, ldb = LDB, K = KK; };
struct StaticOrder {
    int nM, nN, nwg, G, c, pm0;
    __device__ void init(int nM_, int nN_, int G_, int c_, int pm0_ = 0) { nM = nM_; nN = nN_; nwg = nM * nN; G = G_; c = c_; pm0 = pm0_; }
    __device__ bool next(int i, Unit& u) const {
        const long L = (long)i * G + c; if (L >= nwg) return false;
        int wgid = (int)L; { const int q = nwg / NXCD, r = nwg % NXCD, xcd = wgid % NXCD, off = wgid / NXCD; wgid = (xcd < r ? xcd * (q + 1) : r * (q + 1) + (xcd - r) * q) + off; }
        const int nig = WGM * nN, gid = wgid / nig, fm = gid * WGM, gsz = (nM - fm) < WGM ? (nM - fm) : WGM;
        u.pm = pm0 + fm + ((wgid % nig) % gsz); u.pn = (wgid % nig) / gsz; u.koff = 0; u.ks = 0; return true;
    }
    __device__ __forceinline__ void a_ready(const Unit&) const {}
    __device__ __forceinline__ void done(const Unit&) const {}
};

struct SplitOrder {
    int nN, NS, KS, nwg, G, c, pm0, pn0;
    __device__ void init(int nM_, int nN_, int NS_, int KS_, int G_, int c_, int pm0_, int pn0_) { nN = nN_; NS = NS_; KS = KS_; nwg = nM_ * nN_ * NS_; G = G_; c = c_; pm0 = pm0_; pn0 = pn0_; }
    __device__ bool next(int i, Unit& u) const {
        const int L = i * G + c; if (L >= nwg) return false;
        const int ks = L % NS, t = L / NS; u.pn = pn0 + t % nN; u.pm = pm0 + t / nN; u.koff = ks * KS; u.ks = ks; return true;
    }
    __device__ __forceinline__ void a_ready(const Unit&) const {}
    __device__ __forceinline__ void done(const Unit&) const {}
};

#define EPI_LOOP_ROWS for (int ai = AI_LO; ai < AI_HI; ++ai) _Pragma("unroll") for (int m = 0; m < 4; ++m)

struct EpiZ {
    static constexpr bool PERM = true, AFTER_DRAIN = false;
    bf16_t* ZA; bf16_t* G0; bf16_t* G1;
    template <int AI_LO = 0, int AI_HI = 2> __device__ __forceinline__ void run(const f32x4 (&acc)[2][2][4][2], const Unit& u, int wr, int wc, int fr, int fq) const {
#pragma unroll
        EPI_LOOP_ROWS { const int row = u.pm * BM + ai * 128 + wr * 64 + m * 16 + fr;
#pragma unroll
            for (int bj = 0; bj < 2; ++bj) { const int c0 = u.pn * BM + bj * 128 + wc * 32 + 8 * fq; f32x4 v0 = acc[ai][bj][m][0], v1 = acc[ai][bj][m][1];
                bf16_t* dst;
                if (c0 < ZAW) dst = ZA + (size_t)row * ZAW + c0;
                else if (c0 < DIN) { const bool g1 = c0 >= OFF_GATE + DM; dst = (g1 ? G1 + (c0 - OFF_GATE - DM) : G0 + (c0 - OFF_GATE)) + (size_t)row * DM;
#pragma unroll
                    for (int i = 0; i < 4; ++i) { v0[i] = sigmoidf_(v0[i]); v1[i] = sigmoidf_(v1[i]); } }
                else continue;
                u32x4 w; w.x = cvt_pk_bf16(v0[0], v0[1]); w.y = cvt_pk_bf16(v0[2], v0[3]); w.z = cvt_pk_bf16(v1[0], v1[1]); w.w = cvt_pk_bf16(v1[2], v1[3]);
                st16(dst, w); }
            __builtin_amdgcn_sched_barrier(0); }
    }
};
template <int MODE, int LDC = DM> struct EpiN {
    static constexpr bool PERM = true, AFTER_DRAIN = false;
    bf16_t* O; const bf16_t* G; const bf16_t* T;
    template <int AI_LO = 0, int AI_HI = 2> __device__ __forceinline__ void run(const f32x4 (&acc)[2][2][4][2], const Unit& u, int wr, int wc, int fr, int fq) const {
        constexpr int NIT = (AI_HI - AI_LO) * 4;
        const int row0 = u.pm * BM + wr * 64 + fr, colb = u.pn * BM + wc * 32 + 8 * fq;
        u32x4 gb[2][2], tb[2][2];
        auto ld = [&](int it, int buf) { const int ai = AI_LO + it / 4, m = it % 4; const size_t off = (size_t)(row0 + ai * 128 + m * 16) * LDC + colb;
            if (MODE == 1) { gb[buf][0] = __builtin_nontemporal_load((const u32x4*)(O + off)); gb[buf][1] = __builtin_nontemporal_load((const u32x4*)(O + off + 128)); }
            if (MODE == 2) { gb[buf][0] = __builtin_nontemporal_load((const u32x4*)(G + off)); gb[buf][1] = __builtin_nontemporal_load((const u32x4*)(G + off + 128)); tb[buf][0] = __builtin_nontemporal_load((const u32x4*)(T + off)); tb[buf][1] = __builtin_nontemporal_load((const u32x4*)(T + off + 128)); } };
        if (MODE != 0) ld(0, 0);
#pragma unroll
        for (int it = 0; it < NIT; ++it) { const int ai = AI_LO + it / 4, m = it % 4, buf = it & 1;
            if (MODE != 0 && it + 1 < NIT) ld(it + 1, buf ^ 1);
#pragma unroll
            for (int bj = 0; bj < 2; ++bj) { const size_t off = (size_t)(row0 + ai * 128 + m * 16) * LDC + colb + bj * 128;
                f32x4 v0 = acc[ai][bj][m][0], v1 = acc[ai][bj][m][1];
                if (MODE == 1) { const u32x4 g = gb[buf][bj];
                    v0[0] *= bflo(g.x); v0[1] *= bfhi(g.x); v0[2] *= bflo(g.y); v0[3] *= bfhi(g.y); v1[0] *= bflo(g.z); v1[1] *= bfhi(g.z); v1[2] *= bflo(g.w); v1[3] *= bfhi(g.w); }
                if (MODE == 2) { const u32x4 g = gb[buf][bj]; const u32x4 t = tb[buf][bj];
                    v0[0] = v0[0] * bflo(g.x) + bflo(t.x); v0[1] = v0[1] * bfhi(g.x) + bfhi(t.x); v0[2] = v0[2] * bflo(g.y) + bflo(t.y); v0[3] = v0[3] * bfhi(g.y) + bfhi(t.y);
                    v1[0] = v1[0] * bflo(g.z) + bflo(t.z); v1[1] = v1[1] * bfhi(g.z) + bfhi(t.z); v1[2] = v1[2] * bflo(g.w) + bflo(t.w); v1[3] = v1[3] * bfhi(g.w) + bfhi(t.w); }
                u32x4 w; w.x = cvt_pk_bf16(v0[0], v0[1]); w.y = cvt_pk_bf16(v0[2], v0[3]); w.z = cvt_pk_bf16(v1[0], v1[1]); w.w = cvt_pk_bf16(v1[2], v1[3]);
                st16(O + off, w); }
            __builtin_amdgcn_sched_barrier(0); }
    }
};
template <int LD, int ROWS, bool F32> struct EpiSlab {
    static constexpr bool PERM = true, AFTER_DRAIN = false;
    void* SL; int col0;
    template <int AI_LO = 0, int AI_HI = 2> __device__ __forceinline__ void run(const f32x4 (&acc)[2][2][4][2], const Unit& u, int wr, int wc, int fr, int fq) const {
#pragma unroll
        EPI_LOOP_ROWS { const int row = u.pm * BM + ai * 128 + wr * 64 + m * 16 + fr;
#pragma unroll
            for (int bj = 0; bj < 2; ++bj) { const int c0 = u.pn * BM + bj * 128 + wc * 32 + 8 * fq - col0; const size_t off = ((size_t)u.ks * ROWS + row) * LD + c0;
                const f32x4 v0 = acc[ai][bj][m][0], v1 = acc[ai][bj][m][1];
                if (F32) { *(f32x4*)((float*)SL + off) = v0; *(f32x4*)((float*)SL + off + 4) = v1; }
                else { u32x4 w; w.x = cvt_pk_bf16(v0[0], v0[1]); w.y = cvt_pk_bf16(v0[2], v0[3]); w.z = cvt_pk_bf16(v1[0], v1[1]); w.w = cvt_pk_bf16(v1[2], v1[3]); st16((bf16_t*)SL + off, w); } } }
    }
};
struct EpiGU {
    static constexpr bool PERM = true, AFTER_DRAIN = false;
    bf16_t* ACT;
    template <int AI_LO = 0, int AI_HI = 2> __device__ __forceinline__ void run(const f32x4 (&acc)[2][2][4][2], const Unit& u, int wr, int wc, int fr, int fq) const {
#pragma unroll
        EPI_LOOP_ROWS { const int row = u.pm * BM + ai * 128 + wr * 64 + m * 16 + fr; const int c0 = u.pn * 128 + wc * 32 + 8 * fq;
            f32x4 g0 = acc[ai][0][m][0], g1 = acc[ai][0][m][1]; const f32x4 u0 = acc[ai][1][m][0], u1 = acc[ai][1][m][1];
#pragma unroll
            for (int i = 0; i < 4; ++i) { g0[i] = g0[i] * sigmoidf_(g0[i]) * u0[i]; g1[i] = g1[i] * sigmoidf_(g1[i]) * u1[i]; }
            u32x4 w; w.x = cvt_pk_bf16(g0[0], g0[1]); w.y = cvt_pk_bf16(g0[2], g0[3]); w.z = cvt_pk_bf16(g1[0], g1[1]); w.w = cvt_pk_bf16(g1[2], g1[3]);
            st16(ACT + (size_t)row * DFF + c0, w);
            __builtin_amdgcn_sched_barrier(0); }
    }
};

template <int AI, class Epi, class GemmT>
__device__ __forceinline__ void gemm_simple_half(const GemmT& g, const Unit& u, const Epi& E, int wr, int wc, int fr, int fq) {
    f32x4 acc[2][2][4][2];
#pragma unroll
    for (int b = 0; b < 2; ++b)
#pragma unroll
        for (int m = 0; m < 4; ++m)
#pragma unroll
            for (int n = 0; n < 2; ++n) acc[AI][b][m][n] = (f32x4){0.f, 0.f, 0.f, 0.f};
    const bf16_t* Ab = g.A + (size_t)(u.pm * BM + AI * 128 + wr * 64 + fr) * g.lda + u.koff;
    const bf16_t* Bb = g.Bt + (size_t)(u.pn * BM + wc * 32 + 8 * fq) * g.ldb + u.koff;
    for (int k0 = 0; k0 < g.K; k0 += 4) {
        float af[4][4];
#pragma unroll
        for (int m = 0; m < 4; ++m) { const u32x2 a = *(const u32x2*)(Ab + (size_t)(m * 16) * g.lda + k0);
            af[m][0] = bflo(a.x); af[m][1] = bfhi(a.x); af[m][2] = bflo(a.y); af[m][3] = bfhi(a.y); }
#pragma unroll
        for (int bj = 0; bj < 2; ++bj)
#pragma unroll
            for (int n = 0; n < 2; ++n)
#pragma unroll
                for (int i = 0; i < 4; ++i) { const u32x2 b = *(const u32x2*)(Bb + (size_t)(bj * 128 + 4 * n + i) * g.ldb + k0);
                    float bf[4]; bf[0] = bflo(b.x); bf[1] = bfhi(b.x); bf[2] = bflo(b.y); bf[3] = bfhi(b.y);
#pragma unroll
                    for (int m = 0; m < 4; ++m) { float sacc = acc[AI][bj][m][n][i];
#pragma unroll
                        for (int k = 0; k < 4; ++k) sacc += af[m][k] * bf[k];
                        acc[AI][bj][m][n][i] = sacc; } }
    }
    E.template run<AI, AI + 1>(acc, u, wr, wc, fr, fq);
}
template <class Epi, class Sched, class GemmT>
__device__ __forceinline__ void gemm_simple(const GemmT g, const Sched& S, const Epi& E) {
    const int tid = threadIdx.x, wid = tid >> 6, lane = tid & 63, wr = wid >> 2, wc = wid & 3, fr = lane & 15, fq = lane >> 4;
    Unit u;
    for (int it = 0; S.next(it, u); ++it) { gemm_simple_half<0, Epi, GemmT>(g, u, E, wr, wc, fr, fq); gemm_simple_half<1, Epi, GemmT>(g, u, E, wr, wc, fr, fq); }
}

#define PG8_LAS __attribute__((address_space(3)))
constexpr int BK = 64, HALF = 128, HTB = HALF * BK * 2  , STAGE_BYTES = 8 * HTB;
__host__ __device__ __forceinline__ int lds_byte(int r, int c) { const int st = (r >> 4) * 2 + (c >> 5), rr = r & 15, cc = c & 31, ob = rr * 64 + cc * 2; return st * 1024 + (ob ^ (((ob >> 9) & 1) << 5)); }
__host__ __device__ __forceinline__ void stage_rc(int b, int& R, int& C) { const int st = b / 1024, sb = b % 1024, swz = sb ^ (((sb >> 9) & 1) << 5); R = (st >> 1) * 16 + swz / 64; C = (st & 1) * 32 + (swz % 64) / 2; }
__host__ __device__ __forceinline__ int perm32(int rho) { const int n = rho >> 4, i = rho & 15; return 8 * (i >> 2) + 4 * n + (i & 3); }
template <class Epi, class Sched, bool ALIGN_EPI, bool SP2, class GemmT>
__device__ __forceinline__ void gemm_phase(PG8_LAS unsigned char* lds, const GemmT g, const Sched& S, const Epi& E) {
    int tid_l = threadIdx.x; asm volatile("" : "+v"(tid_l));
    const int tid = tid_l, wid = __builtin_amdgcn_readfirstlane(tid >> 6), lane = tid & 63, wr = wid >> 2, wc = wid & 3, fr = lane & 15, fq = lane >> 4;
    constexpr int K = GemmT::K, nt = K / BK; constexpr int lda = GemmT::lda, ldb = GemmT::ldb;
    unsigned voffA[2], voffB[2];
#pragma unroll
    for (int i = 0; i < 2; ++i) { int R, C; stage_rc(tid * 16 + i * 8192, R, C); const int Rb = Epi::PERM ? ((R & ~31) + perm32(R & 31)) : R;
        voffA[i] = (unsigned)(R * lda + C) * 2u; voffB[i] = (unsigned)(Rb * ldb + C) * 2u; }
    const size_t kstep = (size_t)(BK * 2);
    const size_t hstepA = (size_t)HALF * lda * 2, hstepB = (size_t)HALF * ldb * 2;
    const size_t tstepA = 2 * hstepA, tstepB = 2 * hstepB;
    const unsigned ldsw = (unsigned)wid * 1024u;
    const int aoff = lds_byte(wr * 64 + fr, fq * 8), boff = lds_byte(wc * 32 + fr, fq * 8);
#define PG8_SA(b, h) (((b) * 2 + (h)) * HTB)
#define PG8_SB(b, h) ((4 + (b) * 2 + (h)) * HTB)
#define PG8_STAGE(bufoff, gbase, voff) do { _Pragma("unroll") for (int _i = 0; _i < 2; ++_i) { unsigned _o = (voff)[_i]; asm volatile("" : "+v"(_o)); \
        __builtin_amdgcn_global_load_lds((const unsigned*)((const char*)(gbase) + _o), (PG8_LAS unsigned*)(lds + (bufoff) + ldsw + _i * 8192), 16, 0, 0); } } while (0)
#define PG8_LDA(dst, b, h) do { _Pragma("unroll") for (int m = 0; m < 4; ++m) _Pragma("unroll") for (int k = 0; k < 2; ++k) dst[m][k] = *(const PG8_LAS bf16x8*)(lds + PG8_SA(b, h) + aoff + m * 2048 + k * 1024); } while (0)
#define PG8_LDB(dst, b, h) do { _Pragma("unroll") for (int n = 0; n < 2; ++n) _Pragma("unroll") for (int k = 0; k < 2; ++k) dst[n][k] = *(const PG8_LAS bf16x8*)(lds + PG8_SB(b, h) + boff + n * 2048 + k * 1024); } while (0)
#define PG8_MMA(ai, bj, At, Bt) do { __builtin_amdgcn_s_setprio(1); _Pragma("unroll") for (int m = 0; m < 4; ++m) _Pragma("unroll") for (int n = 0; n < 2; ++n) _Pragma("unroll") for (int k = 0; k < 2; ++k) \
        acc[ai][bj][m][n] = __builtin_amdgcn_mfma_f32_16x16x32_bf16(Bt[n][k], At[m][k], acc[ai][bj][m][n], 0, 0, 0); __builtin_amdgcn_s_setprio(0); } while (0)
#define PG8_WAIT_V(n) asm volatile("s_waitcnt vmcnt(" #n ")" ::: "memory")
#define PG8_WAIT_L(n) asm volatile("s_waitcnt lgkmcnt(" #n ")" ::: "memory")
#define PG8_BAR __builtin_amdgcn_s_barrier()
#define PG8_SCHED __builtin_amdgcn_sched_barrier(0)
    Unit cur, nxt; int ui = 0;
    if (!S.next(0, cur)) return;
    f32x4 acc[2][2][4][2];
#pragma unroll
    for (int a = 0; a < 2; ++a)
#pragma unroll
        for (int b = 0; b < 2; ++b)
#pragma unroll
            for (int m = 0; m < 4; ++m)
#pragma unroll
                for (int n = 0; n < 2; ++n) acc[a][b][m][n] = (f32x4){0.f, 0.f, 0.f, 0.f};
    bf16x8 At[4][2], B0[2][2], B1[2][2];
    const char* cA = (const char*)g.A + (size_t)cur.pm * tstepA + (size_t)cur.koff * 2; const char* cB = (const char*)g.Bt + (size_t)cur.pn * tstepB + (size_t)cur.koff * 2;
    S.a_ready(cur);
    if constexpr (SP2) {
        PG8_STAGE(PG8_SB(0, 0), cB, voffB); PG8_STAGE(PG8_SB(0, 1), cB + hstepB, voffB); PG8_STAGE(PG8_SA(0, 0), cA, voffA); PG8_STAGE(PG8_SA(0, 1), cA + hstepA, voffA);
        if (wr == 1) PG8_BAR;
        PG8_WAIT_V(2); PG8_BAR;
        PG8_STAGE(PG8_SB(1, 0), cB + kstep, voffB); PG8_STAGE(PG8_SA(1, 0), cA + kstep, voffA); PG8_STAGE(PG8_SB(1, 1), cB + hstepB + kstep, voffB);
        PG8_WAIT_V(6); PG8_BAR;
    } else {
        PG8_STAGE(PG8_SB(0, 0), cB, voffB); PG8_STAGE(PG8_SA(0, 0), cA, voffA); PG8_STAGE(PG8_SB(0, 1), cB + hstepB, voffB); PG8_STAGE(PG8_SA(0, 1), cA + hstepA, voffA);
        if (wr == 1) PG8_BAR;
        PG8_WAIT_V(4); PG8_BAR;
        PG8_STAGE(PG8_SB(1, 0), cB + kstep, voffB); PG8_STAGE(PG8_SA(1, 0), cA + kstep, voffA); PG8_STAGE(PG8_SB(1, 1), cB + hstepB + kstep, voffB);
        PG8_WAIT_V(6); PG8_BAR;
    }
    for (;;) {
        const bool has_next = S.next(ui + 1, nxt);
        const char* nA = has_next ? (const char*)g.A + (size_t)nxt.pm * tstepA + (size_t)nxt.koff * 2 : cA; const char* nB = has_next ? (const char*)g.Bt + (size_t)nxt.pn * tstepB + (size_t)nxt.koff * 2 : cB;
#pragma nounroll
        for (int t = 0; t < nt; t += 2) {
            const bool last = (t == nt - 2);
            const char* a1 = cA + (size_t)(t + 1) * kstep;
            const char* a2 = last ? nA : cA + (size_t)(t + 2) * kstep; const char* b2 = last ? nB : cB + (size_t)(t + 2) * kstep;
            const char* a3 = a2 + kstep; const char* b3 = b2 + kstep;
            if (last && has_next) S.a_ready(nxt);
            if constexpr (SP2) {
            PG8_LDB(B0, 0, 0); PG8_LDB(B1, 0, 1); PG8_SCHED; PG8_LDA(At, 0, 0); PG8_STAGE(PG8_SA(1, 1), a1 + hstepA, voffA);
            PG8_WAIT_V(8); PG8_WAIT_L(0); PG8_BAR; PG8_MMA(0, 0, At, B0); PG8_MMA(0, 1, At, B1); PG8_BAR; PG8_SCHED;
            PG8_LDA(At, 0, 1); PG8_STAGE(PG8_SB(0, 0), b2, voffB); PG8_STAGE(PG8_SB(0, 1), b2 + hstepB, voffB); PG8_STAGE(PG8_SA(0, 0), a2, voffA);
            PG8_WAIT_V(8); PG8_WAIT_L(0); PG8_BAR; PG8_MMA(1, 0, At, B0); PG8_MMA(1, 1, At, B1); PG8_BAR; PG8_SCHED;
            PG8_LDB(B0, 1, 0); PG8_LDB(B1, 1, 1); PG8_SCHED; PG8_LDA(At, 1, 0); PG8_STAGE(PG8_SA(0, 1), a2 + hstepA, voffA);
            PG8_WAIT_V(8); PG8_WAIT_L(0); PG8_BAR; PG8_MMA(0, 0, At, B0); PG8_MMA(0, 1, At, B1); PG8_BAR; PG8_SCHED;
            PG8_LDA(At, 1, 1); PG8_STAGE(PG8_SB(1, 0), b3, voffB); PG8_STAGE(PG8_SB(1, 1), b3 + hstepB, voffB); PG8_STAGE(PG8_SA(1, 0), a3, voffA);
            PG8_WAIT_V(8); PG8_WAIT_L(0); PG8_BAR; PG8_MMA(1, 0, At, B0); PG8_MMA(1, 1, At, B1); PG8_BAR; PG8_SCHED;
            } else {
            PG8_LDB(B0, 0, 0); PG8_SCHED; PG8_LDA(At, 0, 0); PG8_STAGE(PG8_SA(1, 1), a1 + hstepA, voffA);
            PG8_WAIT_L(8); PG8_BAR; PG8_WAIT_L(0); PG8_MMA(0, 0, At, B0); PG8_BAR; PG8_SCHED;
            PG8_LDB(B1, 0, 1); PG8_STAGE(PG8_SB(0, 0), b2, voffB);
            PG8_BAR; PG8_WAIT_L(0); PG8_MMA(0, 1, At, B1); PG8_BAR;
            PG8_LDA(At, 0, 1); PG8_STAGE(PG8_SA(0, 0), a2, voffA);
            PG8_BAR; PG8_WAIT_L(0); PG8_MMA(1, 0, At, B0); PG8_BAR; PG8_SCHED;
            PG8_STAGE(PG8_SB(0, 1), b2 + hstepB, voffB);
            PG8_WAIT_V(6); PG8_BAR; PG8_MMA(1, 1, At, B1); PG8_BAR;
            PG8_LDB(B0, 1, 0); PG8_SCHED; PG8_LDA(At, 1, 0); PG8_STAGE(PG8_SA(0, 1), a2 + hstepA, voffA);
            PG8_WAIT_L(8); PG8_BAR; PG8_WAIT_L(0); PG8_MMA(0, 0, At, B0); PG8_BAR; PG8_SCHED;
            PG8_LDB(B1, 1, 1); PG8_STAGE(PG8_SB(1, 0), b3, voffB);
            PG8_BAR; PG8_WAIT_L(0); PG8_MMA(0, 1, At, B1); PG8_BAR;
            PG8_LDA(At, 1, 1); PG8_STAGE(PG8_SA(1, 0), a3, voffA);
            PG8_BAR; PG8_WAIT_L(0); PG8_MMA(1, 0, At, B0); PG8_BAR; PG8_SCHED;
            PG8_STAGE(PG8_SB(1, 1), b3 + hstepB, voffB);
            PG8_WAIT_V(6); PG8_BAR; PG8_MMA(1, 1, At, B1); PG8_BAR;
            }
        }
        if constexpr (ALIGN_EPI) { if (wr == 0) PG8_BAR; }
        if constexpr (!Epi::AFTER_DRAIN) { E.template run<0, 2>(acc, cur, wr, wc, fr, fq); S.done(cur); }
        if (!has_next) break;
#pragma unroll
        for (int a = 0; a < 2; ++a)
#pragma unroll
            for (int b = 0; b < 2; ++b)
#pragma unroll
                for (int m = 0; m < 4; ++m)
#pragma unroll
                    for (int n = 0; n < 2; ++n) acc[a][b][m][n] = (f32x4){0.f, 0.f, 0.f, 0.f};
        cur = nxt; cA = nA; cB = nB; ++ui;
        if constexpr (ALIGN_EPI) { if (wr == 1) PG8_BAR; }
    }
    PG8_WAIT_V(0);
    if constexpr (!ALIGN_EPI) { if (wr == 0) PG8_BAR; }
    PG8_BAR;
    if constexpr (Epi::AFTER_DRAIN) { E.fused(acc, cur, wr, wc, fr, fq, lds, wid, lane); S.done(cur); }
#undef PG8_SA
#undef PG8_SB
#undef PG8_STAGE
#undef PG8_LDA
#undef PG8_LDB
#undef PG8_MMA
#undef PG8_WAIT_V
#undef PG8_WAIT_L
#undef PG8_BAR
#undef PG8_SCHED
}

template <class Epi, class GemmT, class Sched>
__device__ __forceinline__ void gemm_phase_any(unsigned char* lds, const GemmT g, const Sched& S, const Epi& E) {
#if USE_MFMA_GEMM
    gemm_phase<Epi, Sched, GEMM_ALIGN, GEMM_SP2, GemmT>((PG8_LAS unsigned char*)lds, g, S, E);
#else
    gemm_simple<Epi, Sched, GemmT>(g, S, E);
#endif
}

__device__ __forceinline__ void q_fixup(float (&v)[8], int row, int col0, float rs, const f32x2* tab) {
#pragma unroll
    for (int i = 0; i < 8; ++i) v[i] *= rs;
    if (col0 >= 128 && row >= NCTX) { const int tpos = (row - NCTX) & (SEQ - 1), p0 = (col0 - 128) >> 1, axis = p0 >> 4, f0 = p0 & 15;
        const f32x2* tb = tab + (axis ? (tpos & 63) : (tpos >> 6)) * 16 + f0;
#pragma unroll
        for (int i = 0; i < 4; ++i) { const f32x2 t = tb[i]; const float a = v[2 * i], b = v[2 * i + 1]; v[2 * i] = a * t.x - b * t.y; v[2 * i + 1] = a * t.y + b * t.x; } }
}
__device__ __forceinline__ void attn_simple_unit(unsigned char* lds, const bf16_t* Q, const bf16_t* KL, bf16_t* O, const float* rstdq, const f32x2* tab, int qrow0, int h, int key0, int nkeys) {
    bf16_t* Qs = (bf16_t*)lds;
    float* Ks = (float*)(lds + 256 * 194 * 2);
    int t_l = threadIdx.x; asm volatile("" : "+v"(t_l));
    const int t = t_l, row = t >> 1, half = t & 1;
    __syncthreads();
    for (int i = t; i < 256 * 24; i += NTHREADS) { const int r = i / 24, c0 = (i % 24) * 8; const u32x4 q = *(const u32x4*)(Q + (size_t)(qrow0 + r) * QW + h * 192 + c0);
        float v[8] = {bflo(q.x), bfhi(q.x), bflo(q.y), bfhi(q.y), bflo(q.z), bfhi(q.z), bflo(q.w), bfhi(q.w)};
        q_fixup(v, qrow0 + r, c0, rstdq[qrow0 + r], tab);
#pragma unroll
        for (int k = 0; k < 8; k += 2) *(unsigned*)(Qs + r * 194 + c0 + k) = cvt_pk_bf16(v[k], v[k + 1]); }
    float m = -1e30f, l = 0.f, acc[64];
#pragma unroll
    for (int d = 0; d < 64; ++d) acc[d] = 0.f;
    for (int j0 = 0; j0 < nkeys; j0 += 16) {
        __syncthreads();
        for (int i = t; i < 16 * 192; i += NTHREADS) { const int j = i / 192, d = i % 192; Ks[j * 193 + d] = bf2f(KL[(size_t)(key0 + j0 + j) * KW + d]); }
        __syncthreads();
        float s[16];
#pragma unroll
        for (int j = 0; j < 16; ++j) s[j] = 0.f;
        for (int d = 0; d < 192; ++d) { const float qv = bf2f(Qs[row * 194 + d]);
#pragma unroll
            for (int j = 0; j < 16; ++j) s[j] += qv * Ks[j * 193 + d]; }
        float mx = s[0];
#pragma unroll
        for (int j = 1; j < 16; ++j) mx = fmaxf(mx, s[j]);
        const float mn = fmaxf(m, mx), alpha = exp2f(m - mn); m = mn;
        float ps = 0.f;
#pragma unroll
        for (int j = 0; j < 16; ++j) { s[j] = exp2f(s[j] - mn); ps += s[j]; }
        l = l * alpha + ps;
#pragma unroll
        for (int d = 0; d < 64; ++d) acc[d] *= alpha;
#pragma unroll 4
        for (int j = 0; j < 16; ++j) { const float p = bf2f((unsigned short)(cvt_pk_bf16(s[j], 0.f) & 0xffffu));
#pragma unroll
            for (int d = 0; d < 64; ++d) acc[d] += p * Ks[j * 193 + half * 64 + d]; }
    }
    const float rl = 1.f / l;
    bf16_t* o = O + (size_t)(qrow0 + row) * DM + h * 128 + half * 64;
#pragma unroll
    for (int d = 0; d < 64; d += 8) { u32x4 w; w.x = cvt_pk_bf16(acc[d] * rl, acc[d + 1] * rl); w.y = cvt_pk_bf16(acc[d + 2] * rl, acc[d + 3] * rl); w.z = cvt_pk_bf16(acc[d + 4] * rl, acc[d + 5] * rl); w.w = cvt_pk_bf16(acc[d + 6] * rl, acc[d + 7] * rl);
        *(u32x4*)(o + d) = w; }
}


namespace attn {
using s16x4 = __attribute__((ext_vector_type(4))) short;
#ifndef ATTN_NBUF
#define ATTN_NBUF 2
#endif
constexpr int NBUF = ATTN_NBUF;
constexpr int KROW = 400, SHM_V = 64 * 128 * 2, SHM_K = 64 * KROW, OFF_K = NBUF * SHM_V, OFF_WS = OFF_K + NBUF * SHM_K, LDS_NEED = OFF_WS + NWAVES * 64 * 4;
static_assert(LDS_NEED <= 131072, "attention LDS");
constexpr float THR2 = 8.f * 1.4426950408889634f;
#define SBAR() __builtin_amdgcn_sched_barrier(0)
__device__ __forceinline__ int crow(int r, int hi) { return (r & 3) + 8 * (r >> 2) + 4 * hi; }
template <int ABL> __device__ __forceinline__ void partialSM(f32x16& p0, f32x16& p1, float& m_reg, float& mn, float& alpha) {
  float pmax = p0[0]; for (int r = 1; r < 16; ++r) pmax = fmaxf(pmax, p0[r]); for (int r = 0; r < 16; ++r) pmax = fmaxf(pmax, p1[r]);
  { auto rr = __builtin_amdgcn_permlane32_swap(__float_as_uint(pmax), __float_as_uint(pmax), false, false);
    pmax = fmaxf(__uint_as_float(rr[0]), __uint_as_float(rr[1])); }
  if (__builtin_expect(__all(pmax - m_reg <= THR2), 1)) { mn = m_reg; alpha = 1.f; }
  else { mn = fmaxf(m_reg, pmax); alpha = __builtin_amdgcn_exp2f(m_reg - mn); m_reg = mn; }
  for (int r = 0; r < 16; ++r) p0[r] = p0[r] - mn; for (int r = 0; r < 16; ++r) p1[r] = p1[r] - mn;
  if (!(ABL & 1)) for (int r = 0; r < 16; ++r) p0[r] = __builtin_amdgcn_exp2f(p0[r]);
}
__device__ __forceinline__ void partialSM_negm(f32x16& p0, f32x16& p1, float& m_reg, float& alpha, f32x16& negm, bool first) {
  float pmax = p0[0]; for (int r = 1; r < 16; ++r) pmax = fmaxf(pmax, p0[r]); for (int r = 0; r < 16; ++r) pmax = fmaxf(pmax, p1[r]);
  { auto rr = __builtin_amdgcn_permlane32_swap(__float_as_uint(pmax), __float_as_uint(pmax), false, false);
    pmax = fmaxf(__uint_as_float(rr[0]), __uint_as_float(rr[1])); }
  if (__builtin_expect(!first && __all(pmax <= THR2), 1)) { alpha = 1.f; }
  else { const float dl = first ? pmax : fmaxf(pmax, 0.f); alpha = __builtin_amdgcn_exp2f(-fmaxf(dl, 0.f)); m_reg += dl; const float nm = -m_reg;
    for (int r = 0; r < 16; ++r) { p0[r] = p0[r] - dl; p1[r] = p1[r] - dl; negm[r] = nm; } }
  for (int r = 0; r < 16; ++r) p0[r] = __builtin_amdgcn_exp2f(p0[r]);
}
template <int ABL> __device__ __forceinline__ void finishSM(f32x16& p0, f32x16& p1, float alpha, float& l_reg, bf16x8& pa0, bf16x8& pa1, bf16x8& pa2, bf16x8& pa3) {
  if (!(ABL & 1)) for (int r = 0; r < 16; ++r) p1[r] = __builtin_amdgcn_exp2f(p1[r]);
  float ps = 0; for (int r = 0; r < 16; ++r) ps += p0[r]; for (int r = 0; r < 16; ++r) ps += p1[r];
  { auto rr = __builtin_amdgcn_permlane32_swap(__float_as_uint(ps), __float_as_uint(ps), false, false);
    ps = __uint_as_float(rr[0]) + __uint_as_float(rr[1]); }
  l_reg = l_reg * alpha + ps;
#if NATIVE_PV
#define PK4(P, BASE, OUT) do { u32x4 w = {cvt_pk_bf16(P[BASE + 0], P[BASE + 1]), cvt_pk_bf16(P[BASE + 2], P[BASE + 3]), cvt_pk_bf16(P[BASE + 4], P[BASE + 5]), cvt_pk_bf16(P[BASE + 6], P[BASE + 7])}; \
    OUT = *reinterpret_cast<bf16x8*>(&w); } while (0)
#else
#define PK4(P, BASE, OUT) do { unsigned a0 = cvt_pk_bf16(P[BASE + 0], P[BASE + 1]), a1 = cvt_pk_bf16(P[BASE + 2], P[BASE + 3]);   \
    unsigned b0 = cvt_pk_bf16(P[BASE + 4], P[BASE + 5]), b1 = cvt_pk_bf16(P[BASE + 6], P[BASE + 7]);                              \
    auto r0 = __builtin_amdgcn_permlane32_swap(a0, b0, false, false); auto r1 = __builtin_amdgcn_permlane32_swap(a1, b1, false, false); \
    u32x4 w = {r0[0], r1[0], r0[1], r1[1]}; OUT = *reinterpret_cast<bf16x8*>(&w); } while (0)
#endif
  PK4(p0, 0, pa0); PK4(p0, 8, pa1); PK4(p1, 0, pa2); PK4(p1, 8, pa3);
#undef PK4
}
template <int ABL> __device__ __forceinline__ void qkt(f32x16& p0, f32x16& p1, const char* Ks, const bf16x8* qr, int r32, int hi) {
  p0 = f32x16{}; p1 = f32x16{};
  if (ABL & 8) { asm volatile("" : "+v"(p0), "+v"(p1)); return; }
#pragma unroll
  for (int d0 = 0; d0 < 12; ++d0) { const int cb = (d0 * 16 + hi * 8) * 2;
    bf16x8 b0, b1;
    if (ABL & 16) { b0 = qr[(d0 + 1) % 12]; b1 = qr[(d0 + 2) % 12]; }
    else { b0 = *reinterpret_cast<const bf16x8*>(Ks + r32 * KROW + cb); b1 = *reinterpret_cast<const bf16x8*>(Ks + (32 + r32) * KROW + cb); }
    p0 = __builtin_amdgcn_mfma_f32_32x32x16_bf16(b0, qr[d0], p0, 0, 0, 0);
    p1 = __builtin_amdgcn_mfma_f32_32x32x16_bf16(b1, qr[d0], p1, 0, 0, 0); }
}
#ifndef QKD
#define QKD 4
#endif
template <int OFF> __device__ __forceinline__ bf16x8 lds_rd128(int addr) { bf16x8 r; asm volatile("ds_read_b128 %0, %1 offset:%2" : "=&v"(r) : "v"(addr), "i"(OFF) : "memory"); return r; }
template <int N> __device__ __forceinline__ void lgkm_wait() { asm volatile("s_waitcnt lgkmcnt(%0)" :: "i"(N) : "memory"); __builtin_amdgcn_sched_barrier(0); }
template <int D0> __device__ __forceinline__ void qk_step(f32x16& p0, f32x16& p1, bf16x8 (&f0)[12], bf16x8 (&f1)[12], const bf16x8* qr, int ka) {
  if constexpr (D0 + QKD < 12) { f0[D0 + QKD] = lds_rd128<(D0 + QKD) * 32>(ka); f1[D0 + QKD] = lds_rd128<32 * KROW + (D0 + QKD) * 32>(ka); }
  constexpr int AHEAD = (11 - D0) < QKD ? (11 - D0) : QKD;
  lgkm_wait<2 * AHEAD>();
  p0 = __builtin_amdgcn_mfma_f32_32x32x16_bf16(f0[D0], qr[D0], p0, 0, 0, 0);
  p1 = __builtin_amdgcn_mfma_f32_32x32x16_bf16(f1[D0], qr[D0], p1, 0, 0, 0);
  if constexpr (D0 + 1 < 12) qk_step<D0 + 1>(p0, p1, f0, f1, qr, ka);
}
__device__ __forceinline__ void qkt_asm(f32x16& p0, f32x16& p1, const char* Ks, const bf16x8* qr, int r32, int hi) {
  p0 = f32x16{}; p1 = f32x16{};
  const int ka = (int)(uintptr_t)Ks + r32 * KROW + hi * 16;
  bf16x8 f0[12], f1[12];
  f0[0] = lds_rd128<0>(ka); f1[0] = lds_rd128<32 * KROW>(ka);
  if constexpr (QKD > 1) { f0[1] = lds_rd128<32>(ka); f1[1] = lds_rd128<32 * KROW + 32>(ka); }
  if constexpr (QKD > 2) { f0[2] = lds_rd128<64>(ka); f1[2] = lds_rd128<32 * KROW + 64>(ka); }
  if constexpr (QKD > 3) { f0[3] = lds_rd128<96>(ka); f1[3] = lds_rd128<32 * KROW + 96>(ka); }
  if constexpr (QKD > 4) { f0[4] = lds_rd128<128>(ka); f1[4] = lds_rd128<32 * KROW + 128>(ka); }
  if constexpr (QKD > 5) { f0[5] = lds_rd128<160>(ka); f1[5] = lds_rd128<32 * KROW + 160>(ka); }
  qk_step<0>(p0, p1, f0, f1, qr, ka);
}
constexpr int KROW2 = 384, SHM_K2 = 64 * KROW2;
template <int D0> __device__ __forceinline__ void qk_step2(f32x16& p0, f32x16& p1, bf16x8 (&f0)[12], bf16x8 (&f1)[12], const bf16x8* qr, const int (&ka)[4]) {
  if constexpr (D0 + QKD < 12) { constexpr int E = D0 + QKD; f0[E] = lds_rd128<(E >> 2) * 128>(ka[E & 3]); f1[E] = lds_rd128<32 * KROW2 + (E >> 2) * 128>(ka[E & 3]); }
  constexpr int AHEAD = (11 - D0) < QKD ? (11 - D0) : QKD;
  lgkm_wait<2 * AHEAD>();
  p0 = __builtin_amdgcn_mfma_f32_32x32x16_bf16(f0[D0], qr[D0], p0, 0, 0, 0);
  p1 = __builtin_amdgcn_mfma_f32_32x32x16_bf16(f1[D0], qr[D0], p1, 0, 0, 0);
  if constexpr (D0 + 1 < 12) qk_step2<D0 + 1>(p0, p1, f0, f1, qr, ka);
}
__device__ __forceinline__ void qkt_asm2(f32x16& p0, f32x16& p1, int kb, int t, const bf16x8* qr) {
  p0 = f32x16{}; p1 = f32x16{};
  const int ka[4] = {kb + ((0 ^ t) << 5), kb + ((1 ^ t) << 5), kb + ((2 ^ t) << 5), kb + ((3 ^ t) << 5)};
  bf16x8 f0[12], f1[12];
  f0[0] = lds_rd128<0>(ka[0]); f1[0] = lds_rd128<32 * KROW2>(ka[0]);
  if constexpr (QKD > 1) { f0[1] = lds_rd128<0>(ka[1]); f1[1] = lds_rd128<32 * KROW2>(ka[1]); }
  if constexpr (QKD > 2) { f0[2] = lds_rd128<0>(ka[2]); f1[2] = lds_rd128<32 * KROW2>(ka[2]); }
  if constexpr (QKD > 3) { f0[3] = lds_rd128<0>(ka[3]); f1[3] = lds_rd128<32 * KROW2>(ka[3]); }
  static_assert(QKD <= 4, "qkt_asm2 prefetch depth");
  qk_step2<0>(p0, p1, f0, f1, qr, ka);
}
__device__ __forceinline__ int v_st(int k, int c) { const int kk = NATIVE_PV ? k : ((k & ~0xC) | ((k & 4) << 1) | ((k & 8) >> 1)); return ((kk >> 3) * 4 + (c >> 5)) * 512 + ((kk & 7) * 32 + (c & 31)) * 2; }
__device__ __forceinline__ int v_rd_base(int lane) { return ((lane & 3) << 3) | (((lane >> 2) & 3) << 6) | (((lane >> 4) & 1) << 5) | (((lane >> 5) & 1) << 8); }
constexpr int v_rd_off(int d0, int ks, int half) { return d0 * 512 + ks * 4096 + half * 2048; }
template <int OFF> __device__ __forceinline__ s16x4 tr_read(int vb) {
  s16x4 r; asm volatile("ds_read_b64_tr_b16 %0, %1 offset:%2" : "=&v"(r) : "v"(vb), "i"(OFF) : "memory"); return r;
}
template <int D0, int ABL = 0> __device__ __forceinline__ void pv_one(f32x16& od, int vb, bf16x8 pa0, bf16x8 pa1, bf16x8 pa2, bf16x8 pa3) {
  if (ABL & 16) { od = __builtin_amdgcn_mfma_f32_32x32x16_bf16(pa0, pa1, od, 0, 0, 0); od = __builtin_amdgcn_mfma_f32_32x32x16_bf16(pa1, pa2, od, 0, 0, 0); od = __builtin_amdgcn_mfma_f32_32x32x16_bf16(pa2, pa3, od, 0, 0, 0); od = __builtin_amdgcn_mfma_f32_32x32x16_bf16(pa3, pa0, od, 0, 0, 0); return; }
  const s16x4 l0 = tr_read<v_rd_off(D0, 0, 0)>(vb), h0 = tr_read<v_rd_off(D0, 0, 1)>(vb), l1 = tr_read<v_rd_off(D0, 1, 0)>(vb), h1 = tr_read<v_rd_off(D0, 1, 1)>(vb);
  const s16x4 l2 = tr_read<v_rd_off(D0, 2, 0)>(vb), h2 = tr_read<v_rd_off(D0, 2, 1)>(vb), l3 = tr_read<v_rd_off(D0, 3, 0)>(vb), h3 = tr_read<v_rd_off(D0, 3, 1)>(vb);
  asm volatile("s_waitcnt lgkmcnt(0)" ::: "memory"); SBAR();
#define PK(L, H) (bf16x8){L[0], L[1], L[2], L[3], H[0], H[1], H[2], H[3]}
  od = __builtin_amdgcn_mfma_f32_32x32x16_bf16(pa0, PK(l0, h0), od, 0, 0, 0);
  od = __builtin_amdgcn_mfma_f32_32x32x16_bf16(pa1, PK(l1, h1), od, 0, 0, 0);
  od = __builtin_amdgcn_mfma_f32_32x32x16_bf16(pa2, PK(l2, h2), od, 0, 0, 0);
  od = __builtin_amdgcn_mfma_f32_32x32x16_bf16(pa3, PK(l3, h3), od, 0, 0, 0);
#undef PK
}
template <int ABL> __device__ __forceinline__ void pv_d0(f32x16* o, int vb, bf16x8 pa0, bf16x8 pa1, bf16x8 pa2, bf16x8 pa3) {
  if (ABL & 4) { asm volatile("" :: "v"(pa0), "v"(pa1), "v"(pa2), "v"(pa3)); return; }
  pv_one<0, ABL>(o[0], vb, pa0, pa1, pa2, pa3); pv_one<1, ABL>(o[1], vb, pa0, pa1, pa2, pa3); pv_one<2, ABL>(o[2], vb, pa0, pa1, pa2, pa3); pv_one<3, ABL>(o[3], vb, pa0, pa1, pa2, pa3);
}
template <int B> __device__ __forceinline__ void v_rd_blk(s16x4 (&vl)[4][4], s16x4 (&vh)[4][4], int vb) {
  vl[B][0] = tr_read<v_rd_off(B, 0, 0)>(vb); vh[B][0] = tr_read<v_rd_off(B, 0, 1)>(vb); vl[B][1] = tr_read<v_rd_off(B, 1, 0)>(vb); vh[B][1] = tr_read<v_rd_off(B, 1, 1)>(vb);
  vl[B][2] = tr_read<v_rd_off(B, 2, 0)>(vb); vh[B][2] = tr_read<v_rd_off(B, 2, 1)>(vb); vl[B][3] = tr_read<v_rd_off(B, 3, 0)>(vb); vh[B][3] = tr_read<v_rd_off(B, 3, 1)>(vb);
}
template <int B> __device__ __forceinline__ void pv_blk(f32x16& od, const s16x4 (&vl)[4][4], const s16x4 (&vh)[4][4], bf16x8 pa0, bf16x8 pa1, bf16x8 pa2, bf16x8 pa3) {
#define PKV(k) (bf16x8){vl[B][k][0], vl[B][k][1], vl[B][k][2], vl[B][k][3], vh[B][k][0], vh[B][k][1], vh[B][k][2], vh[B][k][3]}
  od = __builtin_amdgcn_mfma_f32_32x32x16_bf16(pa0, PKV(0), od, 0, 0, 0); od = __builtin_amdgcn_mfma_f32_32x32x16_bf16(pa1, PKV(1), od, 0, 0, 0);
  od = __builtin_amdgcn_mfma_f32_32x32x16_bf16(pa2, PKV(2), od, 0, 0, 0); od = __builtin_amdgcn_mfma_f32_32x32x16_bf16(pa3, PKV(3), od, 0, 0, 0);
#undef PKV
}
template <int D> __device__ __forceinline__ void k_rd_blk(bf16x8 (&f0)[12], bf16x8 (&f1)[12], const int (&ka)[4]) { f0[D] = lds_rd128<(D >> 2) * 128>(ka[D & 3]); f1[D] = lds_rd128<32 * KROW2 + (D >> 2) * 128>(ka[D & 3]); }
template <bool PVF, bool QKF>
__device__ __forceinline__ void m_seg(f32x16& p0, f32x16& p1, f32x16* o, bf16x8 pa0, bf16x8 pa1, bf16x8 pa2, bf16x8 pa3, int kb, int kt, int vb, const bf16x8* qr, const f32x16& negm) {
  static_assert(QKD == 4, "m_seg assumes QKD == 4");
  const int ka[4] = {kb + ((0 ^ kt) << 5), kb + ((1 ^ kt) << 5), kb + ((2 ^ kt) << 5), kb + ((3 ^ kt) << 5)};
  bf16x8 f0[12], f1[12]; s16x4 vl[4][4], vh[4][4];
  SBAR();
  if (PVF) { v_rd_blk<0>(vl, vh, vb); v_rd_blk<1>(vl, vh, vb); }
  if (QKF) { k_rd_blk<0>(f0, f1, ka); k_rd_blk<1>(f0, f1, ka); }
  if (PVF) {
    lgkm_wait<8 + (QKF ? 4 : 0)>(); pv_blk<0>(o[0], vl, vh, pa0, pa1, pa2, pa3); v_rd_blk<2>(vl, vh, vb); SBAR();
    lgkm_wait<8 + (QKF ? 4 : 0)>(); pv_blk<1>(o[1], vl, vh, pa0, pa1, pa2, pa3); v_rd_blk<3>(vl, vh, vb); SBAR();
    lgkm_wait<8>(); pv_blk<2>(o[2], vl, vh, pa0, pa1, pa2, pa3); if (QKF) { k_rd_blk<2>(f0, f1, ka); k_rd_blk<3>(f0, f1, ka); } SBAR();
    lgkm_wait<(QKF ? 4 : 0)>(); pv_blk<3>(o[3], vl, vh, pa0, pa1, pa2, pa3); SBAR();
  } else if (QKF) { k_rd_blk<2>(f0, f1, ka); k_rd_blk<3>(f0, f1, ka); }
#if SM_NEGM
  if (QKF) {
    if constexpr (QKD + 0 < 12) { f0[QKD] = lds_rd128<(QKD >> 2) * 128>(ka[QKD & 3]); f1[QKD] = lds_rd128<32 * KROW2 + (QKD >> 2) * 128>(ka[QKD & 3]); }
    lgkm_wait<2 * QKD>();
    p0 = __builtin_amdgcn_mfma_f32_32x32x16_bf16(f0[0], qr[0], negm, 0, 0, 0);
    p1 = __builtin_amdgcn_mfma_f32_32x32x16_bf16(f1[0], qr[0], negm, 0, 0, 0);
    qk_step2<1>(p0, p1, f0, f1, qr, ka); }
#else
  if (QKF) { p0 = f32x16{}; p1 = f32x16{}; qk_step2<0>(p0, p1, f0, f1, qr, ka); }
#endif
}
#ifndef ATTN_SDEPTH
#define ATTN_SDEPTH 2
#endif
constexpr int SDEPTH = ATTN_SDEPTH;
template <int ABL = 0> __device__ __forceinline__ void unit(char* lds, const bf16_t* __restrict__ Qg, const bf16_t* __restrict__ Kb, bf16_t* __restrict__ Og, const float* rstdq, const f32x2* tab,
                                     int qrow0, int h, int nkeys) {
  int tid_l = threadIdx.x; asm volatile("" : "+v"(tid_l));
  const int tid = tid_l, wid = tid >> 6, lane = tid & 63, r32 = lane & 31, hi = lane >> 5;
  char* V_lds = lds; char* K_lds = lds + OFF_K;
  float* ws = (float*)(lds + OFF_WS) + wid * 64; float* li_l = ws; float* al_l = ws + 32;
  float m_reg = -1e30f, l_reg = 0; f32x16 o[4] = {}; bf16x8 qr[12];
  { const int row = qrow0 + wid * 32 + r32; const float rs = rstdq[row]; const bf16_t* Qw = Qg + (size_t)row * QW + h * 192 + hi * 8;
#pragma unroll
    for (int d0 = 0; d0 < 12; ++d0) { const u32x4 q = *(const u32x4*)(Qw + d0 * 16);
      float v[8] = {bflo(q.x), bfhi(q.x), bflo(q.y), bfhi(q.y), bflo(q.z), bfhi(q.z), bflo(q.w), bfhi(q.w)};
      q_fixup(v, row, d0 * 16 + hi * 8, rs, tab);
      u32x4 w = {cvt_pk_bf16(v[0], v[1]), cvt_pk_bf16(v[2], v[3]), cvt_pk_bf16(v[4], v[5]), cvt_pk_bf16(v[6], v[7])}; qr[d0] = *reinterpret_cast<bf16x8*>(&w); } }
  const int sr = tid >> 4, sc = (tid & 15) * 8, vst0 = v_st(sr, sc), vst1 = v_st(32 + sr, sc);
  const int kst0 = sr * KROW + sc * 2, kst1 = (32 + sr) * KROW + sc * 2, rr = tid >> 3, rc = 128 + (tid & 7) * 8, kst2 = rr * KROW + rc * 2;
  const int vb0 = (int)(uintptr_t)V_lds + v_rd_base(lane);
  struct { bf16x8 ks0, ks1, kr; } sr_[SDEPTH];
#define SLOAD(i, k0) do { if ((ABL & 2) && (k0) > 128) break; sr_[i].ks0 = *(const bf16x8*)(Kb + (size_t)((k0) + sr) * KW + sc); sr_[i].ks1 = *(const bf16x8*)(Kb + (size_t)((k0) + 32 + sr) * KW + sc); \
    sr_[i].kr = *(const bf16x8*)(Kb + (size_t)((k0) + rr) * KW + rc); } while (0)
#define SWRITE(b, i) do { if ((ABL & 2) && nowrite) break; *(bf16x8*)(V_lds + (b) * SHM_V + vst0) = sr_[i].ks0; *(bf16x8*)(V_lds + (b) * SHM_V + vst1) = sr_[i].ks1; \
    *(bf16x8*)(K_lds + (b) * SHM_K + kst0) = sr_[i].ks0; *(bf16x8*)(K_lds + (b) * SHM_K + kst1) = sr_[i].ks1; *(bf16x8*)(K_lds + (b) * SHM_K + kst2) = sr_[i].kr; } while (0)
#define LSYNC() do { if (!(ABL & 2)) __syncthreads(); } while (0)
#define SWAIT() do { if (ABL & 2) break; if (SDEPTH == 2) asm volatile("s_waitcnt vmcnt(3)" ::: "memory"); else asm volatile("s_waitcnt vmcnt(0)" ::: "memory"); } while (0)
#define RESC(a) do { if (__any((a) < 1.f)) { if (hi == 0) al_l[r32] = (a); asm volatile("s_waitcnt lgkmcnt(0)" ::: "memory"); \
    for (int d = 0; d < 4; ++d) for (int r = 0; r < 16; ++r) o[d][r] *= al_l[crow(r, hi)]; } } while (0)
  bool nowrite = false;
  f32x16 pA0, pA1, pB0, pB1; float mnA, mnB, alA, alB; bf16x8 pa0, pa1, pa2, pa3; const int NT = nkeys / 64;
  constexpr int SE = 0, SO = SDEPTH - 1;
  __syncthreads();
  SLOAD(SE, 0); asm volatile("s_waitcnt vmcnt(0)" ::: "memory"); SWRITE(0, SE); __syncthreads();
  qkt<ABL>(pA0, pA1, K_lds, qr, r32, hi); partialSM<ABL>(pA0, pA1, m_reg, mnA, alA);
  SLOAD(SO, 64); if (SDEPTH == 2 && 2 < NT) SLOAD(SE, 2 * 64);
  if (2 < NT) SWAIT(); else asm volatile("s_waitcnt vmcnt(0)" ::: "memory");
  SWRITE(1, SO); __syncthreads();
  nowrite = true;
  int ib_qk = 1, ib_pv = 0, ib_wr = (NBUF == 3) ? 2 : 0;
#define ROT() do { ib_pv = ib_qk; ib_qk = ib_wr; ib_wr = (NBUF == 3) ? (ib_wr == 2 ? 0 : ib_wr + 1) : (ib_wr ^ 1); } while (0)
#define PRE_WRITE_SYNC() do { if (NBUF == 2) LSYNC(); } while (0)
  for (int j = 1; j + 1 < NT; j += 2) {
    SBAR(); qkt<ABL>(pB0, pB1, K_lds + ib_qk * SHM_K, qr, r32, hi);
    finishSM<ABL>(pA0, pA1, alA, l_reg, pa0, pa1, pa2, pa3); SBAR();
    SLOAD(SO, (j + SDEPTH) * 64); SBAR();
    pv_d0<ABL>(o, vb0 + ib_pv * SHM_V, pa0, pa1, pa2, pa3); partialSM<ABL>(pB0, pB1, m_reg, mnB, alB);
    PRE_WRITE_SYNC(); SWAIT(); SWRITE(ib_wr, SE);
    RESC(alB); LSYNC(); ROT();
    SBAR(); qkt<ABL>(pA0, pA1, K_lds + ib_qk * SHM_K, qr, r32, hi);
    finishSM<ABL>(pB0, pB1, alB, l_reg, pa0, pa1, pa2, pa3); SBAR();
    if (SDEPTH == 1 || j + 3 < NT) SLOAD(SE, (j + 1 + SDEPTH) * 64); SBAR();
    pv_d0<ABL>(o, vb0 + ib_pv * SHM_V, pa0, pa1, pa2, pa3); partialSM<ABL>(pA0, pA1, m_reg, mnA, alA);
    PRE_WRITE_SYNC(); if (SDEPTH == 2 && j + 3 < NT) SWAIT(); else asm volatile("s_waitcnt vmcnt(0)" ::: "memory");
    SWRITE(ib_wr, SO);
    RESC(alA); LSYNC(); ROT();
  }
  SBAR(); qkt<ABL>(pB0, pB1, K_lds + ib_qk * SHM_K, qr, r32, hi);
  finishSM<ABL>(pA0, pA1, alA, l_reg, pa0, pa1, pa2, pa3); SBAR();
  pv_d0<ABL>(o, vb0 + ib_pv * SHM_V, pa0, pa1, pa2, pa3); partialSM<ABL>(pB0, pB1, m_reg, mnB, alB);
  __syncthreads(); RESC(alB);
  finishSM<ABL>(pB0, pB1, alB, l_reg, pa0, pa1, pa2, pa3); SBAR();
  pv_d0<ABL>(o, vb0 + ib_qk * SHM_V, pa0, pa1, pa2, pa3);
#undef ROT
#undef PRE_WRITE_SYNC
  if (hi == 0) li_l[r32] = l_reg; asm volatile("s_waitcnt lgkmcnt(0)" ::: "memory");
  bf16_t* Ow = Og + (size_t)(qrow0 + wid * 32) * DM + h * 128;
  const bool odd = lane & 1;
#pragma unroll
  for (int r = 0; r < 16; r += 2) { const float ra = __builtin_amdgcn_rcpf(li_l[crow(r, hi)]), rb = __builtin_amdgcn_rcpf(li_l[crow(r + 1, hi)]);
#pragma unroll
    for (int d0 = 0; d0 < 4; ++d0) { const float a = o[d0][r] * ra, b = o[d0][r + 1] * rb;
      const float recv = __shfl_xor(odd ? a : b, 1);
      const unsigned w = odd ? cvt_pk_bf16(recv, b) : cvt_pk_bf16(a, recv);
      const int orow = crow(odd ? r + 1 : r, hi);
      *(unsigned*)(Ow + (size_t)orow * DM + d0 * 32 + (r32 & ~1)) = w; } }
#undef SLOAD
#undef SWRITE
#undef SWAIT
#undef LSYNC
#undef RESC
}
#undef SBAR
}


namespace attn2 {
using namespace attn;
#define SBAR() __builtin_amdgcn_sched_barrier(0)
template <bool GX, int AB2 = 0>
__device__ __forceinline__ void unit(char* lds, const bf16_t* __restrict__ Qg, const bf16_t* __restrict__ Kb, bf16_t* __restrict__ Og, const float* rstdq, const f32x2* tab,
                                     int qrow0, int h, int nkeys) {
  int tid_l = threadIdx.x; asm volatile("" : "+v"(tid_l));
  const int tid = tid_l, wid = tid >> 6, lane = tid & 63, r32 = lane & 31, hi = lane >> 5;
  const int lw = ATTN2_GSEL == 0 ? (wid & 3) : ATTN2_GSEL == 1 ? (wid >> 1) : ((wid & 1) | ((wid >> 2) << 1)), gt = lw * 64 + lane;
  constexpr int SHK = ATTN2_DMA ? SHM_K2 : SHM_K;
  char* V_lds = lds; char* K_lds = lds + 2 * SHM_V;
  float* ws = (float*)(lds + 2 * SHM_V + 2 * SHK) + wid * 64; float* li_l = ws; float* al_l = ws + 32;
  float m_reg = -1e30f, l_reg = 0; f32x16 o[4] = {}; bf16x8 qr[12];
  { const int row = qrow0 + wid * 32 + r32; const float rs = rstdq[row]; const bf16_t* Qw = Qg + (size_t)row * QW + h * 192 + hi * 8;
#pragma unroll
    for (int d0 = 0; d0 < 12; ++d0) { const u32x4 q = *(const u32x4*)(Qw + d0 * 16);
      float v[8] = {bflo(q.x), bfhi(q.x), bflo(q.y), bfhi(q.y), bflo(q.z), bfhi(q.z), bflo(q.w), bfhi(q.w)};
      q_fixup(v, row, d0 * 16 + hi * 8, rs, tab);
      u32x4 w = {cvt_pk_bf16(v[0], v[1]), cvt_pk_bf16(v[2], v[3]), cvt_pk_bf16(v[4], v[5]), cvt_pk_bf16(v[6], v[7])}; qr[d0] = *reinterpret_cast<bf16x8*>(&w); } }
  const int vb0 = (int)(uintptr_t)V_lds + v_rd_base(lane);
#if ATTN2_DMA
  const int lwu = __builtin_amdgcn_readfirstlane(lw);
  unsigned koff[GX ? 6 : 1];
  if (GX) {
#pragma unroll
    for (int j = 0; j < 6; ++j) { const int q = 64 * (j % 3) + lane, rr = q / 24, cc = q - 24 * rr, r = 8 * (2 * lw + j / 3) + rr; koff[j] = (unsigned)(r * 384 + ((cc ^ ((r >> 1) & 7)) << 4)); }
  } else koff[0] = (unsigned)((((gt >> 7) * 8 + ((gt >> 2) & 7)) * 384) + ((gt >> 5) & 3) * 64 + (gt & 3) * 16);
  const int sw_ = (r32 >> 1) & 7, kb0 = (int)(uintptr_t)K_lds + r32 * KROW2 + ((hi ^ (sw_ & 1)) << 4), kt = sw_ >> 1;
#define DMA_K(t) do { const char* src_ = (const char*)Kb + (size_t)(t) * (64 * KW * 2); char* dst_ = K_lds + ((t) & 1) * SHM_K2 + lwu * 6144; \
    _Pragma("unroll") for (int j = 0; j < 6; ++j) __builtin_amdgcn_global_load_lds((const unsigned*)(src_ + koff[j]), (__attribute__((address_space(3))) unsigned*)(dst_ + j * 1024), 16, 0, 0); } while (0)
#define DMA_V(t) do { const char* src_ = (const char*)Kb + (size_t)(t) * (64 * KW * 2) + koff[0]; char* dst_ = V_lds + ((t) & 1) * SHM_V + lwu * 1024; \
    _Pragma("unroll") for (int i = 0; i < 4; ++i) __builtin_amdgcn_global_load_lds((const unsigned*)(src_ + i * (16 * KW * 2)), (__attribute__((address_space(3))) unsigned*)(dst_ + i * 4096), 16, 0, 0); } while (0)
#define VM0() asm volatile("s_waitcnt vmcnt(0)" ::: "memory")
#define QKT(k) qkt_asm2(p0, p1, kb0 + ((k) & 1) * SHM_K2, kt, qr)
#else
#define QKT(k) qkt_asm(p0, p1, K_lds + ((k) & 1) * SHM_K, qr, r32, hi)
#endif
  constexpr int NCH = ATTN2_DMA ? 1 : (GX ? 6 : 4);
  bf16x8 stg[NCH];
#define STAGE_LOAD(t) do { _Pragma("unroll") for (int i = 0; i < NCH; ++i) { const int id = gt + 256 * i; \
    stg[i] = GX ? *(const bf16x8*)(Kb + (size_t)(t) * 64 * KW + id * 8) : *(const bf16x8*)(Kb + (size_t)((t) * 64 + (id >> 4)) * KW + (id & 15) * 8); } } while (0)
#define STAGE_WRITE(t) do { _Pragma("unroll") for (int i = 0; i < NCH; ++i) { const int id = gt + 256 * i; \
    if (GX) { const int key = (id * 2731) >> 16; *(bf16x8*)(K_lds + ((t) & 1) * SHM_K + id * 16 + key * 16) = stg[i]; } \
    else *(bf16x8*)(V_lds + ((t) & 1) * SHM_V + v_st(id >> 4, (id & 15) * 8)) = stg[i]; } } while (0)
#define RESC(a) do { if (__any((a) < 1.f)) { if (hi == 0) al_l[r32] = (a); asm volatile("s_waitcnt lgkmcnt(0)" ::: "memory"); \
    for (int d = 0; d < 4; ++d) for (int r = 0; r < 16; ++r) o[d][r] *= al_l[crow(r, hi)]; } } while (0)
  f32x16 p0 = {}, p1 = {}; float mn = 0.f, al = 1.f; bf16x8 pa0 = {}, pa1 = {}, pa2 = {}, pa3 = {}; const int NT = nkeys / 64;
  __syncthreads();
#if ATTN2_DMA
  if (GX) { DMA_K(0); VM0(); }
#else
  if (GX) { STAGE_LOAD(0); STAGE_WRITE(0); }
#endif
  __syncthreads();
#if ATTN2_DMA && ATTN2_MSEG
#define MSEG(PVF, QKF, k) m_seg<PVF, QKF>(p0, p1, o, pa0, pa1, pa2, pa3, kb0 + ((k) & 1) * SHM_K2, kt, vb0 + (((k) - 1) & 1) * SHM_V, qr, negm)
#if SM_NEGM
  f32x16 negm = {}; bool first = true; m_reg = 0.f;
#define SOFTMAX() do { partialSM_negm(p0, p1, m_reg, al, negm, first); first = false; RESC(al); finishSM<0>(p0, p1, al, l_reg, pa0, pa1, pa2, pa3); } while (0)
#else
  const f32x16 negm = {};
#define SOFTMAX() do { partialSM<0>(p0, p1, m_reg, mn, al); RESC(al); finishSM<0>(p0, p1, al, l_reg, pa0, pa1, pa2, pa3); } while (0)
#endif
  if (GX) {
    if (1 < NT) DMA_K(1); SBAR(); MSEG(false, true, 0); __syncthreads();
    SBAR(); SOFTMAX(); SBAR(); VM0(); __syncthreads();
    for (int k = 1; k < NT; ++k) {
      if (k + 1 < NT) DMA_K(k + 1); SBAR(); MSEG(true, true, k); __syncthreads();
      SBAR(); SOFTMAX(); SBAR(); VM0(); __syncthreads();
    }
    MSEG(true, false, NT); __syncthreads(); __syncthreads();
  } else {
    DMA_V(0); __syncthreads();
    SBAR(); MSEG(false, true, 0); VM0(); __syncthreads();
    for (int k = 1; k < NT; ++k) {
      DMA_V(k); SBAR(); SOFTMAX(); SBAR(); __syncthreads();
      SBAR(); MSEG(true, true, k); VM0(); __syncthreads();
    }
    SBAR(); SOFTMAX(); SBAR(); __syncthreads();
    MSEG(true, false, NT); __syncthreads();
  }
#undef MSEG
#undef SOFTMAX
#else
  for (int k = 0; k <= NT; ++k) {
    if (GX) {
      __builtin_amdgcn_s_setprio(ATTN2_PM); SBAR();
#if ATTN2_DMA
      if (k + 1 < NT) DMA_K(k + 1);
      SBAR();
#endif
#if ATTN2_DMA && ATTN2_MSEG
      { const int kbk = kb0 + (k & 1) * SHM_K2, vbk = vb0 + ((k - 1) & 1) * SHM_V;
        if (k >= 1 && k < NT) m_seg<true, true>(p0, p1, o, pa0, pa1, pa2, pa3, kbk, kt, vbk, qr); else if (k < NT) m_seg<false, true>(p0, p1, o, pa0, pa1, pa2, pa3, kbk, kt, vbk, qr); else m_seg<true, false>(p0, p1, o, pa0, pa1, pa2, pa3, kbk, kt, vbk, qr); }
#else
      if (k >= 1) { if (!(AB2 & 2)) pv_d0<0>(o, vb0 + ((k - 1) & 1) * SHM_V, pa0, pa1, pa2, pa3); else { asm volatile("" :: "v"(pa0), "v"(pa1), "v"(pa2), "v"(pa3)); asm volatile("" : "+v"(o[0]), "+v"(o[1]), "+v"(o[2]), "+v"(o[3])); } }
      if (k < NT) { if (!(AB2 & 2)) QKT(k); else asm volatile("" : "+v"(p0), "+v"(p1)); }
#endif
      __syncthreads();
      __builtin_amdgcn_s_setprio(ATTN2_PV); SBAR();
#if !ATTN2_DMA
      if (k + 1 < NT) STAGE_LOAD(k + 1);
#endif
      SBAR();
      if (k < NT) { if (!(AB2 & 1)) { partialSM<0>(p0, p1, m_reg, mn, al); RESC(al); finishSM<0>(p0, p1, al, l_reg, pa0, pa1, pa2, pa3); } else { asm volatile("" :: "v"(p0), "v"(p1)); asm volatile("" : "+v"(pa0), "+v"(pa1), "+v"(pa2), "+v"(pa3)); } }
      SBAR();
#if ATTN2_DMA
      VM0();
#else
      if (k + 1 < NT) STAGE_WRITE(k + 1);
#endif
      __syncthreads();
    } else {
      __builtin_amdgcn_s_setprio(ATTN2_PV); SBAR();
#if ATTN2_DMA
      if (k < NT) DMA_V(k);
#else
      if (k < NT) STAGE_LOAD(k);
#endif
      SBAR();
      if (k >= 1) { if (!(AB2 & 1)) { partialSM<0>(p0, p1, m_reg, mn, al); RESC(al); finishSM<0>(p0, p1, al, l_reg, pa0, pa1, pa2, pa3); } else { asm volatile("" :: "v"(p0), "v"(p1)); asm volatile("" : "+v"(pa0), "+v"(pa1), "+v"(pa2), "+v"(pa3)); } }
      SBAR();
#if !ATTN2_DMA
      if (k < NT) STAGE_WRITE(k);
#endif
      __syncthreads();
      __builtin_amdgcn_s_setprio(ATTN2_PM); SBAR();
#if ATTN2_DMA && ATTN2_MSEG
      { const int kbk = kb0 + (k & 1) * SHM_K2, vbk = vb0 + ((k - 1) & 1) * SHM_V;
        if (k >= 1 && k < NT) m_seg<true, true>(p0, p1, o, pa0, pa1, pa2, pa3, kbk, kt, vbk, qr); else if (k < NT) m_seg<false, true>(p0, p1, o, pa0, pa1, pa2, pa3, kbk, kt, vbk, qr); else m_seg<true, false>(p0, p1, o, pa0, pa1, pa2, pa3, kbk, kt, vbk, qr); }
#else
      if (k >= 1) { if (!(AB2 & 2)) pv_d0<0>(o, vb0 + ((k - 1) & 1) * SHM_V, pa0, pa1, pa2, pa3); else { asm volatile("" :: "v"(pa0), "v"(pa1), "v"(pa2), "v"(pa3)); asm volatile("" : "+v"(o[0]), "+v"(o[1]), "+v"(o[2]), "+v"(o[3])); } }
      if (k < NT) { if (!(AB2 & 2)) QKT(k); else asm volatile("" : "+v"(p0), "+v"(p1)); }
#endif
#if ATTN2_DMA
      VM0();
#endif
      __syncthreads();
    }
  }
#endif
  __builtin_amdgcn_s_setprio(0);
  if (hi == 0) li_l[r32] = l_reg; asm volatile("s_waitcnt lgkmcnt(0)" ::: "memory");
  bf16_t* Ow = Og + (size_t)(qrow0 + wid * 32) * DM + h * 128;
  const bool odd = lane & 1;
#pragma unroll
  for (int r = 0; r < 16; r += 2) { const float ra = __builtin_amdgcn_rcpf(li_l[crow(r, hi)]), rb = __builtin_amdgcn_rcpf(li_l[crow(r + 1, hi)]);
#pragma unroll
    for (int d0 = 0; d0 < 4; ++d0) { const float a = o[d0][r] * ra, b = o[d0][r + 1] * rb;
      const float recv = __shfl_xor(odd ? a : b, 1);
      const unsigned w = odd ? cvt_pk_bf16(recv, b) : cvt_pk_bf16(a, recv);
      const int orow = crow(odd ? r + 1 : r, hi);
      *(unsigned*)(Ow + (size_t)orow * DM + d0 * 32 + (r32 & ~1)) = w; } }
#undef STAGE_LOAD
#undef STAGE_WRITE
#undef RESC
#undef QKT
#if ATTN2_DMA
#undef DMA_K
#undef DMA_V
#undef VM0
#endif
}
#undef SBAR
}

template <class Src>
__device__ __forceinline__ void transpose_item(bf16_t* WT, int K, int item, int nblk, float* scr, int lane, const Src& src, const bool NTS = false) {
    const int kb = item / nblk, nb = item % nblk, k0 = 64 * kb, n0 = 32 * nb;
    float tv[32];
#pragma unroll
    for (int i = 0; i < 32; ++i) tv[i] = src(k0 + 2 * i + (lane >> 5), n0 + (lane & 31));
#pragma unroll
    for (int i = 0; i < 32; ++i) { const int kk = 2 * i + (lane >> 5); scr[kk * 33 + (lane & 31)] = tv[i]; }
    asm volatile("s_waitcnt lgkmcnt(0)" ::: "memory");
    const int c = lane & 7;
#pragma unroll
    for (int j = 0; j < 4; ++j) { const int n = (lane >> 3) + 8 * j; const float* s = scr + (8 * c) * 33 + n;
        u32x4 o; o.x = cvt_pk_bf16(s[0 * 33], s[1 * 33]); o.y = cvt_pk_bf16(s[2 * 33], s[3 * 33]); o.z = cvt_pk_bf16(s[4 * 33], s[5 * 33]); o.w = cvt_pk_bf16(s[6 * 33], s[7 * 33]);
        if (NTS) __builtin_nontemporal_store(o, (u32x4*)(WT + (size_t)(n0 + n) * K + k0 + 8 * c)); else *(u32x4*)(WT + (size_t)(n0 + n) * K + k0 + 8 * c) = o; }
    asm volatile("s_waitcnt lgkmcnt(0)" ::: "memory");
}
template <bool R_DFAST = false, class PF, class RF>
__device__ __forceinline__ void fold_tile(bf16_t* out, int Kout, unsigned char* lds, const PF& P, const RF& R) {
    float* Ps = (float*)lds;
    float* Rt = Ps + 64 * 132;
    bf16_t* Os = (bf16_t*)(Rt + 64 * 132);
    const int t = threadIdx.x;
    __syncthreads();
    { float pv[16], rv[16];
#pragma unroll
      for (int j = 0; j < 16; ++j) { const int i = t + j * NTHREADS; pv[j] = P(i >> 7, i & 127); }
#pragma unroll
      for (int j = 0; j < 16; ++j) { const int i = t + j * NTHREADS; rv[j] = R(R_DFAST ? (i & 127) : (i >> 6), R_DFAST ? (i >> 7) : (i & 63)); }
#pragma unroll
      for (int j = 0; j < 16; ++j) { const int i = t + j * NTHREADS; Ps[(i >> 7) * 132 + (i & 127)] = pv[j]; }
#pragma unroll
      for (int j = 0; j < 16; ++j) { const int i = t + j * NTHREADS; const int d = R_DFAST ? (i & 127) : (i >> 6), nn = R_DFAST ? (i >> 7) : (i & 63); Rt[nn * 132 + d] = rv[j]; } }
    __syncthreads();
    const int nn = t >> 3, kq = t & 7;
    float a[8];
#pragma unroll
    for (int i = 0; i < 8; ++i) a[i] = 0.f;
    for (int d4 = 0; d4 < 32; ++d4) { const f32x4 r = *(const f32x4*)(Rt + nn * 132 + d4 * 4);
#pragma unroll
        for (int i = 0; i < 8; ++i) { const f32x4 p = *(const f32x4*)(Ps + (kq + 8 * i) * 132 + d4 * 4); a[i] += p.x * r.x + p.y * r.y + p.z * r.z + p.w * r.w; } }
#pragma unroll
    for (int i = 0; i < 8; ++i) Os[nn * 72 + kq + 8 * i] = (bf16_t)(cvt_pk_bf16(a[i], 0.f) & 0xffffu);
    __syncthreads();
    *(u32x4*)(out + (size_t)nn * Kout + kq * 8) = *(const u32x4*)(Os + nn * 72 + kq * 8);
}

__device__ __forceinline__ void p0_transposes(const Ctx& C, unsigned char* lds, const int l, const int worker, const int nw) {
    {
        float* scr = (float*)(lds + C.wave * 16384);
        const int gw = worker * NWAVES + C.wave, NGW = nw * NWAVES;
        constexpr int I_IN = (DM / 64) * (NIN / 32), I_QR = (QL / 64) * (NH * 64 / 32), I_OUT = (DM / 64) * (DM / 32), I_GU = (DM / 64) * (NGU / 32), I_DN = (DFF / 64) * (DM / 32);
        constexpr int PER_LAYER = I_IN + I_QR + I_OUT + I_GU + I_DN;
        for (int it = gw; it < PER_LAYER; it += NGW) {
            int r = it;
            bf16_t* W = (bf16_t*)(C.ws + WS_W + (size_t)l * LW_BYTES);
            if (r < I_IN) { const float* w = C.in(7) + (size_t)l * DM * DIN;
                transpose_item(W + W_IN, DM, r, NIN / 32, scr, C.lane, [=](int k, int n) { const float v = __builtin_nontemporal_load(w + (size_t)k * DIN + (n < DIN ? n : DIN - 1)); return n < DIN ? v : 0.f; }, l > 0); continue; } r -= I_IN;
            if (r < I_QR) { const float* w = C.in(9) + (size_t)l * QL * QW; const float* gq = C.in(8) + l * QL;
                const int nblk = NH * 64 / 32, kb = r / nblk, nb = r % nblk, hh = nb >> 1, e0 = (nb & 1) * 32;
                bf16_t* dst = W + W_Q + (size_t)(hh * 192 + 128 + e0 - 32 * nb) * QL;
                transpose_item(dst, QL, kb * nblk + nb, nblk, scr, C.lane, [=](int k, int n) { const int e = n & 63, hd = n >> 6, p = e >> 1, comp = e & 1;
                    return w[(size_t)k * QW + hd * 192 + 128 + (p >> 4) * 32 + comp * 16 + (p & 15)] * gq[k] * C2; }, l > 0); continue; } r -= I_QR;
            if (r < I_OUT) { const float* w = C.in(16) + (size_t)l * DM * DM;
                transpose_item(W + W_OUT, DM, r, DM / 32, scr, C.lane, [=](int k, int n) { return __builtin_nontemporal_load(w + (size_t)k * DM + n); }, l > 0); continue; } r -= I_OUT;
            if (r < I_GU) { const float* wg = C.in(19) + (size_t)l * DM * DFF; const float* wu = C.in(20) + (size_t)l * DM * DFF;
                transpose_item(W + W_GU, DM, r, NGU / 32, scr, C.lane, [=](int k, int n) { const int tile = n >> 8, hf = (n >> 7) & 1, cc = n & 127; return __builtin_nontemporal_load((hf ? wu : wg) + (size_t)k * DFF + tile * 128 + cc); }, l > 0); continue; } r -= I_GU;
            { const float* w = C.in(21) + (size_t)l * DFF * DM;
                transpose_item(W + W_DN, DFF, r, DM / 32, scr, C.lane, [=](int k, int n) { return __builtin_nontemporal_load(w + (size_t)k * DM + n); }, l > 0); }
        }
    }
}
__device__ __forceinline__ void p0_folds(const Ctx& C, unsigned char* lds, const int l, const int worker, const int nw) {
    {
        constexpr int T_Q = NH * 2 * 4, T_O = 16 * 16, T_PC = 16 * 8, PER_LAYER = T_Q + T_O + T_PC;
        for (int it = worker; it < PER_LAYER; it += nw) {
            int r = it;
            bf16_t* W = (bf16_t*)(C.ws + WS_W + (size_t)l * LW_BYTES);
            const float* w_uq = C.in(9) + (size_t)l * QL * QW; const float* w_ukv = C.in(11) + (size_t)l * KVL * 2048; const float* gq = C.in(8) + l * QL;
            if (r < T_Q) { const int hh = r >> 3, jt = (r >> 2) & 1, itile = r & 3;
                fold_tile<true>(W + W_Q + (size_t)(hh * 192 + jt * 64) * QL + itile * 64, QL, lds,
                          [=](int kk, int d) { const int i = itile * 64 + kk; return w_uq[(size_t)i * QW + hh * 192 + d] * gq[i] * C2; },
                          [=](int d, int nn) { return w_ukv[(size_t)(jt * 64 + nn) * 2048 + hh * 256 + d]; });
                continue; } r -= T_Q;
            if (r < T_O) { const int nt = r >> 4, kt = r & 15, hh = kt >> 1, j0 = (kt & 1) * 64; const float* w_o = C.in(12) + (size_t)l * DM * DM;
                fold_tile(W + W_O + (size_t)(nt * 64) * DM + hh * 128 + j0, DM, lds,
                          [=](int kk, int d) { return w_ukv[(size_t)(j0 + kk) * 2048 + hh * 256 + 128 + d]; },
                          [=](int d, int nn) { return w_o[(size_t)(hh * 128 + d) * DM + nt * 64 + nn]; });
                continue; } r -= T_O;
            { const int nt = r >> 3, kt = r & 7, gg = kt >> 1, c0 = (kt & 1) * 64; const float* w_pool = C.in(13) + ((size_t)l * 4 + gg) * 128 * 128; const float* psc = C.in(14) + l * PW + gg * 128;
              const float* w_op = C.in(15) + (size_t)l * PW * DM;
                fold_tile(W + W_PC + (size_t)(nt * 64) * PW + gg * 128 + c0, PW, lds,
                          [=](int kk, int d) { return w_pool[(size_t)(c0 + kk) * 128 + d] * psc[d]; },
                          [=](int d, int nn) { return w_op[(size_t)(gg * 128 + d) * DM + nt * 64 + nn]; }); }
        }
    }
    __syncthreads();
}
__device__ __forceinline__ void p0_mod_tab(const Ctx& C, unsigned char* lds) {
    const float* w_ada = C.in(4); const float* b_ada = C.in(5);
    {
        float* sv = (float*)lds;
        float* red = sv + 5 * DM;
        float* MOD = (float*)(C.ws + WS_MOD);
        const int t = C.tid, ks = t >> 6, cc = t & 63;
        bool have = false;
        for (int it = C.bid; it < DEPTH * (NMOD * DM / 64); it += C.G) {
            const int l = it / (NMOD * DM / 64), n0 = (it % (NMOD * DM / 64)) * 64;
            __syncthreads();
            if (!have) { for (int i = t; i < 5 * DM; i += NTHREADS) { const int s = i / DM, k = i % DM; const float* src = s < 4 ? C.in(1) + s * DM : C.in(3); const float v = src[k]; sv[i] = v / (1.f + __expf(-v)); } have = true; __syncthreads(); }
            float a0 = 0, a1 = 0, a2 = 0, a3 = 0, a4 = 0;
            const float* Wp = w_ada + (size_t)l * DM * (NMOD * DM) + n0 + cc;
#pragma unroll 32
            for (int k = ks * 128; k < ks * 128 + 128; ++k) { const float w = __builtin_nontemporal_load(Wp + (size_t)k * (NMOD * DM)); a0 += sv[k] * w; a1 += sv[DM + k] * w; a2 += sv[2 * DM + k] * w; a3 += sv[3 * DM + k] * w; a4 += sv[4 * DM + k] * w; }
            red[(ks * 5 + 0) * 64 + cc] = a0; red[(ks * 5 + 1) * 64 + cc] = a1; red[(ks * 5 + 2) * 64 + cc] = a2; red[(ks * 5 + 3) * 64 + cc] = a3; red[(ks * 5 + 4) * 64 + cc] = a4;
            __syncthreads();
            if (t < 320) { const int s = t >> 6; float v = b_ada[l * NMOD * DM + n0 + cc];
#pragma unroll
                for (int q = 0; q < 8; ++q) v += red[(q * 5 + s) * 64 + cc];
                MOD[((size_t)l * 5 + s) * NMOD * DM + n0 + cc] = v; }
        }
        __syncthreads();
    }
    if (C.bid == C.G - 1) {
        f32x2* tab = (f32x2*)(C.ws + WS_TAB);
        for (int i = C.tid; i < 64 * 16; i += NTHREADS) { const int pos = i >> 4, f = i & 15; const float inv = powf(10000.f, -(float)(2 * f) / 32.f), ang = (float)pos * inv;
            tab[i] = (f32x2){cosf(ang), sinf(ang)}; }
    }
}

__device__ __forceinline__ void row_pass(const Ctx& C, int row_lo, int row_hi, bool from_input, const bf16_t* Yb, const float* gpost, int kg,
                                         bf16_t* hdst, const float* gpre, const float* mod_res, const float* mod_h, int ksc, int ksh, const bf16_t* slab = nullptr) {
    const int gw = C.bid * NWAVES + C.wave, NGW = C.G * NWAVES, lane = C.lane;
    for (int r = row_lo + gw; r < row_hi; r += NGW) {
        const int slot = mod_slot(r);
        f32x4 x[4], y[4], gp[4], mg[4], gq[4], sc[4], sh[4];
        if (!XS_BF16 || !Yb || from_input) {
            const f32x4* xr = (const f32x4*)((!Yb || from_input) ? xin_row(C, r) : xs_row(C, r)) + lane;
#pragma unroll
            for (int j = 0; j < 4; ++j) x[j] = __builtin_nontemporal_load(xr + 64 * j);
        } else {
            const u32x2* xr = (const u32x2*)xs_row(C, r) + lane;
#pragma unroll
            for (int j = 0; j < 4; ++j) { const u32x2 xx = __builtin_nontemporal_load(xr + 64 * j); x[j] = (f32x4){bflo(xx.x), bfhi(xx.x), bflo(xx.y), bfhi(xx.y)}; }
        }
        if (Yb) {
            const u32x2* yr = (const u32x2*)(Yb + (size_t)r * DM) + lane;
            if (slab && r < NCTX) {
#pragma unroll
                for (int j = 0; j < 4; ++j) { y[j] = (f32x4){0.f, 0.f, 0.f, 0.f};
                    for (int ks = 0; ks < NSD; ++ks) { const u32x2 yy = ((const u32x2*)(slab + ((size_t)ks * NCTX + r) * DM))[lane + 64 * j]; y[j] += (f32x4){bflo(yy.x), bfhi(yy.x), bflo(yy.y), bfhi(yy.y)}; } }
            } else {
#pragma unroll
                for (int j = 0; j < 4; ++j) { const u32x2 yy = __builtin_nontemporal_load(yr + 64 * j); y[j] = (f32x4){bflo(yy.x), bfhi(yy.x), bflo(yy.y), bfhi(yy.y)}; }
            }
            const float* mgp = mod_res + (size_t)slot * NMOD * DM + kg * DM;
#pragma unroll
            for (int j = 0; j < 4; ++j) { gp[j] = ((const f32x4*)gpost)[lane + 64 * j]; mg[j] = ((const f32x4*)mgp)[lane + 64 * j]; }
        }
        if (hdst) {
            const float* msc = mod_h + (size_t)slot * NMOD * DM + ksc * DM; const float* msh = mod_h + (size_t)slot * NMOD * DM + ksh * DM;
#pragma unroll
            for (int j = 0; j < 4; ++j) { gq[j] = ((const f32x4*)gpre)[lane + 64 * j]; sc[j] = ((const f32x4*)msc)[lane + 64 * j]; sh[j] = ((const f32x4*)msh)[lane + 64 * j]; }
        }
        if (Yb) {
            float ss = 0.f;
#pragma unroll
            for (int j = 0; j < 4; ++j) ss += y[j].x * y[j].x + y[j].y * y[j].y + y[j].z * y[j].z + y[j].w * y[j].w;
            const float rstd = rsqrtf(wave_sum(ss) * (1.f / DM) + EPS);
            float* xp = xs_row(C, r);
#pragma unroll
            for (int j = 0; j < 4; ++j) { x[j] = x[j] + mg[j] * (y[j] * rstd * gp[j]);
                if (!XS_BF16 || !hdst) __builtin_nontemporal_store(x[j], (f32x4*)xp + lane + 64 * j);
                else { u32x2 w; w.x = cvt_pk_bf16(x[j].x, x[j].y); w.y = cvt_pk_bf16(x[j].z, x[j].w); __builtin_nontemporal_store(w, (u32x2*)xp + lane + 64 * j); } }
        }
        if (hdst) {
            float ss = 0.f;
#pragma unroll
            for (int j = 0; j < 4; ++j) ss += x[j].x * x[j].x + x[j].y * x[j].y + x[j].z * x[j].z + x[j].w * x[j].w;
            const float rstd = rsqrtf(wave_sum(ss) * (1.f / DM) + EPS);
            u32x2* hp = (u32x2*)(hdst + (size_t)r * DM) + lane;
#pragma unroll
            for (int j = 0; j < 4; ++j) { const f32x4 hv = x[j] * rstd * gq[j] * (sc[j] + 1.f) + sh[j]; u32x2 w; w.x = cvt_pk_bf16(hv.x, hv.y); w.y = cvt_pk_bf16(hv.z, hv.w); hp[64 * j] = w; }
        }
    }
}

template <int HW>
__device__ __forceinline__ void pool_strip(const bf16_t* ZA, bf16_t* D, int r0, int seq_lo, int seq_hi, int c) {
    float ps[33]; ps[0] = 0.f;
    float v8[16];
    unsigned short raw[32];
#pragma unroll
    for (int i = 0; i < 32; ++i) { int r = r0 - 8 + i; r = r < seq_lo ? seq_lo : (r >= seq_hi ? seq_hi - 1 : r); raw[i] = ZA[(size_t)r * ZAW + OFF_POOL + c]; }
#pragma unroll
    for (int i = 0; i < 32; ++i) { const int r = r0 - 8 + i; const float v = (r >= seq_lo && r < seq_hi) ? bf2f(raw[i]) : 0.f; ps[i + 1] = ps[i] + v; if (i >= 8 && i < 24) v8[i - 8] = v; }
#pragma unroll
    for (int j = 0; j < 16; ++j) { const int pos = r0 + j; int lo = pos - HW; if (lo < seq_lo) lo = seq_lo; int hi = pos + HW; if (hi > seq_hi) hi = seq_hi;
        const float mean = (ps[j + 8 + HW] - ps[j + 8 - HW]) * __builtin_amdgcn_rcpf((float)(hi - lo));
        D[(size_t)pos * PW + c] = (bf16_t)(cvt_pk_bf16(mean - v8[j], 0.f) & 0xffffu); }
}
template <int HW>
__device__ __forceinline__ void pool_strip2(const bf16_t* ZA, bf16_t* D, int r0, int seq_lo, int seq_hi, int c) {
    float pa[33], pb[33]; pa[0] = 0.f; pb[0] = 0.f;
    float va[16], vb[16];
    unsigned raw[32];
#pragma unroll
    for (int i = 0; i < 32; ++i) { int r = r0 - 8 + i; r = r < seq_lo ? seq_lo : (r >= seq_hi ? seq_hi - 1 : r); raw[i] = *(const unsigned*)(ZA + (size_t)r * ZAW + OFF_POOL + c); }
#pragma unroll
    for (int i = 0; i < 32; ++i) { const int r = r0 - 8 + i; const bool in = (r >= seq_lo && r < seq_hi); const float a = in ? bflo(raw[i]) : 0.f, b = in ? bfhi(raw[i]) : 0.f;
        pa[i + 1] = pa[i] + a; pb[i + 1] = pb[i] + b; if (i >= 8 && i < 24) { va[i - 8] = a; vb[i - 8] = b; } }
#pragma unroll
    for (int j = 0; j < 16; ++j) { const int pos = r0 + j; int lo = pos - HW; if (lo < seq_lo) lo = seq_lo; int hi = pos + HW; if (hi > seq_hi) hi = seq_hi;
        const float rc = __builtin_amdgcn_rcpf((float)(hi - lo));
        const float ma = (pa[j + 8 + HW] - pa[j + 8 - HW]) * rc, mb = (pb[j + 8 + HW] - pb[j + 8 - HW]) * rc;
        *(unsigned*)(D + (size_t)pos * PW + c) = cvt_pk_bf16(ma - va[j], mb - vb[j]); }
}
__device__ __forceinline__ void p3a_rowops(const Ctx& C, int l) {
    const bf16_t* ZA = (const bf16_t*)(C.ws + AR_ZA); bf16_t* KL = (bf16_t*)(C.ws + AR_KL); bf16_t* D = (bf16_t*)(C.ws + AR_D);
    float* RSTDQ = (float*)(C.ws + WS_RSTDQ); const f32x2* tab = (const f32x2*)(C.ws + WS_TAB); const float* gkv = C.in(10) + l * KVL;
    const int gw = C.bid * NWAVES + C.wave, NGW = C.G * NWAVES, lane = C.lane, sub = lane >> 4, l16 = lane & 15;
    const float* SLZ = (const float*)(C.ws + WS_SLZ);
    for (int rb = gw * 4; rb < MROWS; rb += NGW * 4) {
        const int r = rb + sub;
        float kv[8], x1a, x1b, x2a, x2b;
        const int p = 2 * l16, axis = p >> 4, f = p & 15;
        if (l > 0 && r < NCTX) {
#pragma unroll
            for (int i = 0; i < 8; ++i) kv[i] = 0.f;
            x1a = x1b = x2a = x2b = 0.f;
#pragma unroll
            for (int ks = 0; ks < 4; ++ks) { const float* sl = SLZ + ((size_t)ks * NCTX + r) * 256; const f32x4 a0 = ((const f32x4*)sl)[2 * l16], a1 = ((const f32x4*)sl)[2 * l16 + 1];
                kv[0] += a0.x; kv[1] += a0.y; kv[2] += a0.z; kv[3] += a0.w; kv[4] += a1.x; kv[5] += a1.y; kv[6] += a1.z; kv[7] += a1.w;
                const f32x2 u1 = *(const f32x2*)(sl + 128 + axis * 32 + f), u2 = *(const f32x2*)(sl + 128 + axis * 32 + 16 + f); x1a += u1.x; x1b += u1.y; x2a += u2.x; x2b += u2.y; }
        } else {
            const bf16_t* z = ZA + (size_t)r * ZAW;
            const u32x4 q0 = ((const u32x4*)z)[2 * l16], q1 = ((const u32x4*)z)[2 * l16 + 1];
            float ss = 0.f;
            { float t; t = bflo(q0.x); ss += t * t; t = bfhi(q0.x); ss += t * t; t = bflo(q0.y); ss += t * t; t = bfhi(q0.y); ss += t * t; t = bflo(q0.z); ss += t * t; t = bfhi(q0.z); ss += t * t; t = bflo(q0.w); ss += t * t; t = bfhi(q0.w); ss += t * t;
              t = bflo(q1.x); ss += t * t; t = bfhi(q1.x); ss += t * t; t = bflo(q1.y); ss += t * t; t = bfhi(q1.y); ss += t * t; t = bflo(q1.z); ss += t * t; t = bfhi(q1.z); ss += t * t; t = bflo(q1.w); ss += t * t; t = bfhi(q1.w); ss += t * t; }
            ss += __shfl_xor(ss, 1); ss += __shfl_xor(ss, 2); ss += __shfl_xor(ss, 4); ss += __shfl_xor(ss, 8);
            if (l16 == 0) RSTDQ[r] = rsqrtf(ss * (1.f / QL) + EPS);
            const u32x4 zk = ((const u32x4*)(z + OFF_KV))[l16];
            kv[0] = bflo(zk.x); kv[1] = bfhi(zk.x); kv[2] = bflo(zk.y); kv[3] = bfhi(zk.y); kv[4] = bflo(zk.z); kv[5] = bfhi(zk.z); kv[6] = bflo(zk.w); kv[7] = bfhi(zk.w);
            const unsigned u1 = *(const unsigned*)(z + OFF_KR + axis * 32 + f), u2 = *(const unsigned*)(z + OFF_KR + axis * 32 + 16 + f);
            x1a = bflo(u1); x1b = bfhi(u1); x2a = bflo(u2); x2b = bfhi(u2);
        }
        float sk = 0.f;
#pragma unroll
        for (int i = 0; i < 8; ++i) sk += kv[i] * kv[i];
        sk += __shfl_xor(sk, 1); sk += __shfl_xor(sk, 2); sk += __shfl_xor(sk, 4); sk += __shfl_xor(sk, 8);
        const float rk = rsqrtf(sk * (1.f / KVL) + EPS);
        bf16_t* kl = KL + (size_t)key_index(r) * KW;
        const f32x4 g0 = ((const f32x4*)gkv)[2 * l16], g1 = ((const f32x4*)gkv)[2 * l16 + 1];
        u32x4 w; w.x = cvt_pk_bf16(kv[0] * rk * g0.x, kv[1] * rk * g0.y); w.y = cvt_pk_bf16(kv[2] * rk * g0.z, kv[3] * rk * g0.w); w.z = cvt_pk_bf16(kv[4] * rk * g1.x, kv[5] * rk * g1.y); w.w = cvt_pk_bf16(kv[6] * rk * g1.z, kv[7] * rk * g1.w);
        ((u32x4*)kl)[l16] = w;
        if (r >= NCTX) { const int tpos = (r - NCTX) & (SEQ - 1); const f32x2* tb = tab + (axis ? (tpos & 63) : (tpos >> 6)) * 16 + f; const f32x2 ca = tb[0], cb = tb[1];
            float a_, b_; a_ = x1a; b_ = x2a; x1a = a_ * ca.x - b_ * ca.y; x2a = a_ * ca.y + b_ * ca.x; a_ = x1b; b_ = x2b; x1b = a_ * cb.x - b_ * cb.y; x2b = a_ * cb.y + b_ * cb.x; }
        u32x2 wr_; wr_.x = cvt_pk_bf16(x1a, x2a); wr_.y = cvt_pk_bf16(x1b, x2b);
        ((u32x2*)(kl + 128))[l16] = wr_;
    }
#if POOL2
    const int c = (C.tid & 255) * 2, gsel = c >> 7;
    for (int s2 = (l > 0 ? NCTX / 32 : 0) + C.bid; s2 < MROWS / 32; s2 += C.G) {
        const int r0 = (2 * s2 + (C.tid >> 8)) * 16; int seq_lo, seq_hi;
        if (r0 < NCTX) { seq_lo = (r0 / CTX) * CTX; seq_hi = seq_lo + CTX; } else { seq_lo = NCTX + ((r0 - NCTX) / SEQ) * SEQ; seq_hi = seq_lo + SEQ; }
        if (gsel == 0) pool_strip2<1>(ZA, D, r0, seq_lo, seq_hi, c);
        else if (gsel == 1) pool_strip2<2>(ZA, D, r0, seq_lo, seq_hi, c);
        else if (gsel == 2) pool_strip2<4>(ZA, D, r0, seq_lo, seq_hi, c);
        else pool_strip2<8>(ZA, D, r0, seq_lo, seq_hi, c);
    }
#else
    const int c = C.tid, gsel = c >> 7;
    for (int s = (l > 0 ? NCTX / 16 : 0) + C.bid; s < MROWS / 16; s += C.G) {
        const int r0 = s * 16; int seq_lo, seq_hi;
        if (r0 < NCTX) { seq_lo = (r0 / CTX) * CTX; seq_hi = seq_lo + CTX; } else { seq_lo = NCTX + ((r0 - NCTX) / SEQ) * SEQ; seq_hi = seq_lo + SEQ; }
        if (gsel == 0) pool_strip<1>(ZA, D, r0, seq_lo, seq_hi, c);
        else if (gsel == 1) pool_strip<2>(ZA, D, r0, seq_lo, seq_hi, c);
        else if (gsel == 2) pool_strip<4>(ZA, D, r0, seq_lo, seq_hi, c);
        else pool_strip<8>(ZA, D, r0, seq_lo, seq_hi, c);
    }
#endif
}

template <int ABL = 0> __device__ __forceinline__ void attn_phase(const Ctx& C, unsigned char* lds, int l) {
    const bf16_t* Q = (const bf16_t*)(C.ws + AR_Q); const bf16_t* KL = (const bf16_t*)(C.ws + AR_KL); bf16_t* O = (bf16_t*)(C.ws + AR_O);
    const float* rstdq = (const float*)(C.ws + WS_RSTDQ); const f32x2* tab = (const f32x2*)(C.ws + WS_TAB);
    const int nlat = NB * NH * (SEQ / 256), nctx = (l == 0) ? NB * NH : 0;
    for (int uid = C.bid; uid < nlat; uid += C.G) { const int b = uid / (NH * 16), h = (uid / 16) % NH, qt = uid % 16;
#if USE_MFMA_ATTN
        if (USE_ATTN2) { if (ATTN2_GSEL == 0 ? C.wave < 4 : ATTN2_GSEL == 1 ? (C.wave & 1) == 0 : (C.wave & 2) == 0) attn2::unit<true, ABL>((char*)lds, Q, KL + (size_t)b * KPB * KW, O, rstdq, tab, NCTX + b * SEQ + qt * 256, h, KPB); else attn2::unit<false, ABL>((char*)lds, Q, KL + (size_t)b * KPB * KW, O, rstdq, tab, NCTX + b * SEQ + qt * 256, h, KPB); }
        else attn::unit<ABL>((char*)lds, Q, KL + (size_t)b * KPB * KW, O, rstdq, tab, NCTX + b * SEQ + qt * 256, h, KPB);
#else
        attn_simple_unit(lds, Q, KL, O, rstdq, tab, NCTX + b * SEQ + qt * 256, h, b * KPB, KPB);
#endif
    }
    for (int v = C.G - 1 - C.bid; v < nctx; v += C.G) { const int b = v / NH, h = v % NH;
#if USE_MFMA_ATTN
        if (USE_ATTN2) { if (ATTN2_GSEL == 0 ? C.wave < 4 : ATTN2_GSEL == 1 ? (C.wave & 1) == 0 : (C.wave & 2) == 0) attn2::unit<true, ABL>((char*)lds, Q, KL + (size_t)b * KPB * KW, O, rstdq, tab, b * CTX, h, CTX); else attn2::unit<false, ABL>((char*)lds, Q, KL + (size_t)b * KPB * KW, O, rstdq, tab, b * CTX, h, CTX); }
        else attn::unit<ABL>((char*)lds, Q, KL + (size_t)b * KPB * KW, O, rstdq, tab, b * CTX, h, CTX);
#else
        attn_simple_unit(lds, Q, KL, O, rstdq, tab, b * CTX, h, b * KPB, CTX);
#endif
    }
}

#define GAS __attribute__((address_space(1)))
#define LAS __attribute__((address_space(3)))
#define XB_TMO      128
#define XB_XCNT(j)  (256  + 64 * (j))
#define XB_XSUB(j)  (1280 + 64 * (j))
#define XB_XGEN(j)  (2304 + 64 * (j))
#define XB_TOP      3328
#define XB_TOPGEN   3392
#define XCD_BAR_WORDS 3456
#define XB_SPIN_CAP (1u << 18)

__device__ __forceinline__ unsigned xb_ld(unsigned* p)              { return __hip_atomic_load(p, __ATOMIC_RELAXED, __HIP_MEMORY_SCOPE_AGENT); }
__device__ __forceinline__ unsigned xb_add(unsigned* p, unsigned v) { return __hip_atomic_fetch_add(p, v, __ATOMIC_RELAXED, __HIP_MEMORY_SCOPE_AGENT); }
__device__ __forceinline__ unsigned xb_xcc_id() { return (unsigned)__builtin_amdgcn_s_getreg((3 << 11) | 20) & 0xFu; }
#define XB_SPIN(cond, bar) do { unsigned _sp = 0; while (cond) { __builtin_amdgcn_s_sleep(1); \
    if ((++_sp & 255u) == 0u) { if (xb_ld(&(bar)[XB_TMO])) break; if (_sp > XB_SPIN_CAP) { atomicAdd(&(bar)[XB_TMO], 1u); break; } } } } while (0)

struct XcdBarrier {
    unsigned* bar; unsigned x;
    volatile LAS unsigned* st;
};

__device__ __forceinline__ XcdBarrier xcd_barrier_post(unsigned* bar, volatile LAS unsigned* st) {
    XcdBarrier b; b.bar = bar; b.x = xb_xcc_id(); b.st = st;
    if (threadIdx.x == 0) (void)xb_add(&bar[XB_XCNT(b.x)], 1u);
    return b;
}
__device__ __forceinline__ void xcd_barrier_complete(unsigned* bar, unsigned x, unsigned& nloc, unsigned& nx) {
    const unsigned G = gridDim.x * gridDim.y * gridDim.z;
    unsigned sum, cnt, mine, sp = 0u;
    for (;;) {
        sum = 0u; cnt = 0u; mine = 0u;
#pragma unroll
        for (unsigned j = 0; j < 16; ++j) { const unsigned c = xb_ld(&bar[XB_XCNT(j)]); sum += c; cnt += (c > 0u) ? 1u : 0u; mine = (j == x) ? c : mine; }
        if (sum == G) break;
        __builtin_amdgcn_s_sleep(1);
        if ((++sp & 255u) == 0u) { if (xb_ld(&bar[XB_TMO])) break; if (sp > XB_SPIN_CAP) { atomicAdd(&bar[XB_TMO], 1u); break; } }
    }
    nloc = mine > 0u ? mine : 1u; nx = cnt > 0u ? cnt : 1u;
}

__device__ __forceinline__ void xcd_barrier(const XcdBarrier& b) {
    asm volatile("s_waitcnt vmcnt(0)" ::: "memory");
    __syncthreads();
    if (threadIdx.x == 0) {
        unsigned* bar = b.bar;
        __builtin_amdgcn_s_waitcnt(0);
        unsigned nloc = b.st[0], nx = b.st[1];
        if (nloc == 0u) { xcd_barrier_complete(bar, b.x, nloc, nx); b.st[0] = nloc; b.st[1] = nx; }
        const unsigned old = xb_add(&bar[XB_XSUB(b.x)], 1u);
        const unsigned gen = old / nloc;
        if (old + 1u == (gen + 1u) * nloc) {
            __builtin_amdgcn_fence(__ATOMIC_RELEASE, "agent");
            asm volatile("s_waitcnt vmcnt(0)" ::: "memory");
            const unsigned og = xb_add(&bar[XB_TOP], 1u);
            const unsigned tg = og / nx;
            if (og + 1u == (tg + 1u) * nx) xb_add(&bar[XB_TOPGEN], 1u);
            else XB_SPIN(xb_ld(&bar[XB_TOPGEN]) == tg, bar);
            __builtin_amdgcn_fence(__ATOMIC_ACQUIRE, "agent");
            xb_add(&bar[XB_XGEN(b.x)], 1u);
            asm volatile("s_waitcnt vmcnt(0)" ::: "memory");
        } else {
            XB_SPIN(xb_ld(&bar[XB_XGEN(b.x)]) == gen, bar);
            __builtin_amdgcn_fence(__ATOMIC_ACQUIRE, "agent");
            asm volatile("s_waitcnt vmcnt(0)" ::: "memory");
        }
    }
    __syncthreads();
}

#define RUN(k) (ph_lo <= (k) && (k) < ph_hi)
#define SEAM() do { if (RUN(phase) && RUN(phase + 1)) { if (USE_CG_FIRST == 1 && phase == 0) grid.sync(); else xcd_barrier(bar); } ++phase; asm volatile("" : "+s"(C.ws), "+s"(C.out), "+s"(C.bid), "+s"(C.G)); ws = C.ws; } while (0)
#define MOD ((float*)(ws + WS_MOD))
#define W ((const bf16_t*)(ws + WS_W + (size_t)l * LW_BYTES))
#define modl (MOD + (size_t)l * 5 * NMOD * DM)
template <int l>
__device__ __forceinline__ void run_layer(Ctx& C, unsigned char* lds, cg::grid_group& grid, const XcdBarrier& bar, int& phase, const int ph_lo, const int ph_hi) {
    gws_t ws = C.ws;
        const bool last = (l == DEPTH - 1);
        constexpr int TM0 = (l == 0) ? 0 : NCTX / BM, TMN = MROWS / BM - TM0;
        constexpr int ROW0 = TM0 * BM;
        if (RUN(phase)) {
            { Gemm<DM, DM, DM> g{(const bf16_t*)(ws + AR_H), W + W_IN}; StaticOrder S; S.init(TMN, NIN / BM, C.G, C.bid, TM0);
              EpiZ E{(bf16_t*)(ws + AR_ZA), (bf16_t*)(ws + AR_G0), (bf16_t*)(ws + AR_G1)}; if (GEMM_ON(0)) gemm_phase_any(lds, g, S, E); if (DUP(3)) gemm_phase_any(lds, g, S, E); }
            if (l > 0) {
              Gemm<DM, DM, 256> g{(const bf16_t*)(ws + AR_H), W + W_IN}; SplitOrder S; S.init(NCTX / BM, 1, 4, 256, C.G, (C.bid + 128) % C.G, 0, 1);
              EpiSlab<256, NCTX, true> E{(void*)(ws + WS_SLZ), 256}; gemm_phase_any(lds, g, S, E); }
        }
        SEAM();
        if (RUN(phase)) {
            { Gemm<ZAW, QL, QL> g{(const bf16_t*)(ws + AR_ZA), W + W_Q}; StaticOrder S; S.init(TMN, QW / BM, C.G, C.bid, TM0);
              EpiN<0, QW> E{(bf16_t*)(ws + AR_Q), nullptr, nullptr}; if (GEMM_ON(1)) gemm_phase_any(lds, g, S, E); }
            p3a_rowops(C, l); if (DUP(2)) p3a_rowops(C, l);
        }
        SEAM();
        if (RUN(phase)) {
            { Gemm<PW, PW, PW> g{(const bf16_t*)(ws + AR_D), W + W_PC}; StaticOrder S; S.init(TMN, DM / BM, C.G, C.bid, TM0);
              EpiN<1> E{(bf16_t*)(ws + AR_G1), nullptr, nullptr}; if (GEMM_ON(2)) gemm_phase_any(lds, g, S, E); }
            if (DUP(1)) attn_phase<ATTN_ABL>(C, lds, l); attn_phase(C, lds, l);
        }
        SEAM();
        if (RUN(phase)) { Gemm<DM, DM, DM> g{(const bf16_t*)(ws + AR_O), W + W_O}; StaticOrder S; S.init(TMN, DM / BM, C.G, C.bid, TM0);
            EpiN<2> E{(bf16_t*)(ws + AR_MG), (const bf16_t*)(ws + AR_G0), (const bf16_t*)(ws + AR_G1)}; if (GEMM_ON(3)) gemm_phase_any(lds, g, S, E); if (DUP(6)) gemm_phase_any(lds, g, S, E);
            if (l == 0 && DEPTH > 1 && C.bid >= LZY0) p0_transposes(C, lds, 1, C.bid - LZY0, C.G - LZY0); }
        SEAM();
        if (RUN(phase)) { Gemm<DM, DM, DM> g{(const bf16_t*)(ws + AR_MG), W + W_OUT}; StaticOrder S; S.init(TMN, DM / BM, C.G, C.bid, TM0);
            EpiN<0> E{(bf16_t*)(ws + AR_Y), nullptr, nullptr}; if (GEMM_ON(4)) gemm_phase_any(lds, g, S, E);
            if (l == 0 && DEPTH > 1 && C.bid >= LZY0) p0_folds(C, lds, 1, C.bid - LZY0, C.G - LZY0); }
        SEAM();
        if (RUN(phase)) row_pass(C, ROW0, MROWS, l == 0, (const bf16_t*)(ws + AR_Y), C.in(17) + l * DM, 2, (bf16_t*)(ws + AR_HF), C.in(18) + l * DM, modl, modl, 3, 4);
        SEAM();
        if (RUN(phase)) { Gemm<DM, DM, DM> g{(const bf16_t*)(ws + AR_HF), W + W_GU}; StaticOrder S; S.init(TMN, NGU / BM, C.G, C.bid, TM0);
            EpiGU E{(bf16_t*)(ws + AR_ACT)}; if (GEMM_ON(5)) gemm_phase_any(lds, g, S, E); if (DUP(4)) gemm_phase_any(lds, g, S, E); }
        SEAM();
        if (RUN(phase)) {
            { Gemm<DFF, DFF, DFF> g{(const bf16_t*)(ws + AR_ACT), W + W_DN}; StaticOrder S; S.init(MROWS / BM - NCTX / BM, DM / BM, C.G, C.bid, NCTX / BM);
              EpiN<0> E{(bf16_t*)(ws + AR_F), nullptr, nullptr}; if (GEMM_ON(6)) gemm_phase_any(lds, g, S, E); if (DUP(5)) gemm_phase_any(lds, g, S, E); }
            if (l == 0) {
              Gemm<DFF, DFF, 256> g{(const bf16_t*)(ws + AR_ACT), W + W_DN}; SplitOrder S; S.init(NCTX / BM, DM / BM, NSD, 256, C.G, C.bid, 0, 0);
              EpiSlab<DM, NCTX, false> E{(void*)(ws + AR_SLD), 0}; gemm_phase_any(lds, g, S, E); }
        }
        SEAM();
        if (RUN(phase)) row_pass(C, ROW0, MROWS, false, (const bf16_t*)(ws + AR_F), C.in(22) + l * DM, 5, last ? nullptr : (bf16_t*)(ws + AR_H),
                                 last ? nullptr : C.in(6) + (l + 1) * DM, modl, last ? nullptr : modl + 5 * NMOD * DM, 0, 1, l == 0 ? (const bf16_t*)(ws + AR_SLD) : nullptr);
        if (!last) SEAM();
}

__global__ void __launch_bounds__(NTHREADS, 2) mega_fwd(Args a) {
    extern __shared__ __attribute__((aligned(16))) unsigned char lds[];
    cg::grid_group grid = cg::this_grid();
    const int tid_ = threadIdx.x;
    Ctx C{(gout_t)a.out, (gws_t)a.ws, tid_, tid_ & 63, __builtin_amdgcn_readfirstlane(tid_ >> 6), (int)gridDim.x, (int)blockIdx.x};
    gws_t ws = C.ws;
    int phase = 0;
    const int ph_lo = a.ph_lo, ph_hi = a.ph_hi;
    if (USE_CG_FIRST == 2 && ph_lo > ph_hi) grid.sync();
    volatile LAS unsigned* bst = (volatile LAS unsigned*)((LAS unsigned char*)lds + LDS_BYTES - 64);
    if (tid_ < 2) bst[tid_] = 0u;
    __syncthreads();
    const XcdBarrier bar = xcd_barrier_post((unsigned*)(C.ws + WS_CTL) + 4096, bst);

#ifndef DIS_P0
    if (RUN(phase)) { p0_transposes(C, lds, 0, C.bid, C.G); p0_folds(C, lds, 0, C.bid, C.G); p0_mod_tab(C, lds); }
#endif
    SEAM();
    if (RUN(phase)) { row_pass(C, 0, MROWS, true, nullptr, nullptr, 0, (bf16_t*)(ws + AR_H), C.in(6), nullptr, MOD, 0, 1); if (DUP(7)) row_pass(C, 0, MROWS, true, nullptr, nullptr, 0, (bf16_t*)(ws + AR_H), C.in(6), nullptr, MOD, 0, 1); }
    SEAM();
    run_layer<0>(C, lds, grid, bar, phase, ph_lo, ph_hi);
    run_layer<1>(C, lds, grid, bar, phase, ph_lo, ph_hi);
}

constexpr int N_PHASES = 2 + 9 * DEPTH;

extern "C" void kernel_launch(void* const* d_in, const int* in_sizes, int n_in, void* d_out, int out_size, void* d_ws, size_t ws_size, hipStream_t stream) {
    static int grid = 0;
    if (grid == 0) {
        if (n_in != 23 || out_size != NB * SEQ * DM || ws_size < WS_END) { fprintf(stderr, "kernel_launch: unexpected shapes (n_in %d out %d ws %zu need %zu)\n", n_in, out_size, ws_size, (size_t)WS_END); grid = -1; return; }
        int dev = 0, cus = 0, per_cu = 0;
        (void)hipGetDevice(&dev); (void)hipDeviceGetAttribute(&cus, hipDeviceAttributeMultiprocessorCount, dev);
        if (hipFuncSetAttribute((const void*)mega_fwd, hipFuncAttributeMaxDynamicSharedMemorySize, LDS_BYTES) != hipSuccess) { fprintf(stderr, "kernel_launch: hipFuncSetAttribute failed\n"); grid = -1; return; }
        if (hipOccupancyMaxActiveBlocksPerMultiprocessor(&per_cu, (const void*)mega_fwd, NTHREADS, LDS_BYTES) != hipSuccess || per_cu < 1) { fprintf(stderr, "kernel_launch: occupancy query says %d\n", per_cu); per_cu = 1; }
        (void)hipGetLastError();
        grid = cus;
        fprintf(stderr, "kernel_launch: grid %d (cus %d, per_cu %d), ws %zu\n", grid, cus, per_cu, ws_size);
    }
    if (grid < 0) return;
    (void)hipMemsetAsync((char*)d_ws + WS_CTL, 0, 64 * 1024, stream);
    Args a{};
    for (int i = 0; i < 23; ++i) a.in[i] = (const float*)d_in[i];
    a.out = (float*)d_out; a.ws = (unsigned char*)d_ws; a.ph_lo = 0; a.ph_hi = N_PHASES;
    void* args[] = {&a};
    hipError_t e = hipLaunchCooperativeKernel((const void*)mega_fwd, dim3(grid), dim3(NTHREADS), args, LDS_BYTES, stream);
    if (e != hipSuccess) fprintf(stderr, "kernel_launch: cooperative launch failed: %s (grid %d)\n", hipGetErrorString(e), grid);
}
```

```cpp
#include <hip/hip_runtime.h>
#include <hip/hip_cooperative_groups.h>
#include <cstdio>
#include <cstdint>
namespace cg = cooperative_groups;

#ifndef USE_MFMA_GEMM
#define USE_MFMA_GEMM 1
#endif
#ifndef GEMM_MASK
#define GEMM_MASK 0xff
#endif
#define GEMM_ON(k) ((GEMM_MASK >> (k)) & 1)
#ifndef PROBE_DUP
#define PROBE_DUP 0
#endif
#define DUP(k) ((PROBE_DUP >> (k)) & 1)
#ifndef ATTN_ABL
#define ATTN_ABL 0
#endif
#ifndef GEMM_ALIGN
#define GEMM_ALIGN true
#endif
#ifndef GEMM_SP2
#define GEMM_SP2 true
#endif
#ifndef USE_ATTN2
#define USE_ATTN2 1
#endif
#ifndef NATIVE_PV
#define NATIVE_PV 1
#endif
#ifndef ATTN2_DMA
#define ATTN2_DMA 1
#endif
#ifndef ATTN2_MSEG
#define ATTN2_MSEG 1
#endif
#ifndef XS_BF16
#define XS_BF16 1
#endif
#ifndef SM_NEGM
#define SM_NEGM 1
#endif
#ifndef POOL2
#define POOL2 1
#endif
#ifndef MOD_WIDE
#define MOD_WIDE 1
#endif
#ifndef FOLD_MFMA
#define FOLD_MFMA 1
#endif
#ifndef P0_LAZY
#define P0_LAZY 1
#endif
#ifndef HOST_ATTN
#define HOST_ATTN 3800
#endif
#ifndef ROW_CHUNK
#define ROW_CHUNK 1
#endif
#ifndef ATTN2_PM
#define ATTN2_PM 0
#endif
#ifndef ATTN2_PV
#define ATTN2_PV 0
#endif
#ifndef ATTN2_GSEL
#define ATTN2_GSEL 0
#endif
#ifndef USE_CG_FIRST
#define USE_CG_FIRST 2
#endif
#ifndef USE_MFMA_ATTN
#define USE_MFMA_ATTN 1
#endif

constexpr int DM = 1024, NB = 4, SEQ = 4096, DEPTH = 2, CTX = 256, NH = 8;
constexpr int QL = 256, KVL = 128, ROPE = 64, PW = 512, DFF = 2816, DIN = 3008, NMOD = 6;
constexpr int OFF_KV = 256, OFF_KR = 384, OFF_POOL = 448, OFF_GATE = 960;
constexpr int NCTX = NB * CTX;
constexpr int MROWS = NCTX + NB * SEQ;
constexpr int ZAW = 960, QW = NH * 192, KW = 192, NIN = 3072, NGU = 2 * DFF;
constexpr int KPB = CTX + SEQ;
constexpr float EPS = 1e-6f;
constexpr float C2 = 0.07216878364870322f * 1.4426950408889634f;
constexpr int NTHREADS = 512, NWAVES = 8;
constexpr int LZY0 = (MROWS / 256) * (DM / 256) - 256;
constexpr int LDS_BYTES = 147456;

typedef unsigned short bf16_t;
typedef short bf16x8 __attribute__((ext_vector_type(8)));
typedef float f32x4 __attribute__((ext_vector_type(4)));
typedef float f32x2 __attribute__((ext_vector_type(2)));
typedef float f32x16 __attribute__((ext_vector_type(16)));
typedef unsigned u32x4 __attribute__((ext_vector_type(4)));
typedef unsigned u32x2 __attribute__((ext_vector_type(2)));

constexpr size_t MiB = 1u << 20;
constexpr size_t WS_CTL = 0;
constexpr size_t WS_MOD = 1 * MiB;
constexpr size_t WS_TAB = WS_MOD + 256 * 1024;
constexpr size_t WS_RSTDQ = WS_TAB + 16 * 1024;
constexpr size_t WS_XC = 2 * MiB;
constexpr size_t WS_W = 6 * MiB;
constexpr size_t W_IN = 0, W_Q = W_IN + (size_t)NIN * DM, W_O = W_Q + (size_t)QW * QL, W_PC = W_O + (size_t)DM * DM, W_OUT = W_PC + (size_t)DM * PW,
                 W_GU = W_OUT + (size_t)DM * DM, W_DN = W_GU + (size_t)NGU * DM, W_END = W_DN + (size_t)DM * DFF;
constexpr size_t LW_BYTES = W_END * 2;
constexpr size_t WS_AR = WS_W + 2 * LW_BYTES + (MiB - (2 * LW_BYTES) % MiB) % MiB;
constexpr size_t AR_G0 = WS_AR, AR_Y = AR_G0, AR_F = AR_G0;
constexpr size_t AR_G1 = WS_AR + 34 * MiB, AR_HF = AR_G1;
constexpr size_t AR_Q = WS_AR + 68 * MiB, AR_H = AR_Q, AR_MG = AR_Q, AR_ACT = AR_Q;
constexpr size_t AR_ZA = WS_AR + 119 * MiB, AR_O = AR_ZA;
constexpr size_t AR_D = WS_AR + 151 * MiB;
constexpr size_t AR_KL = WS_AR + 168 * MiB;
constexpr size_t WS_SLZ = WS_AR + 175 * MiB;
constexpr size_t AR_SLD = AR_G1;
constexpr int NSD = DFF / 256;
constexpr int TR_R0 = (DM / 64) * (NIN / 32) + (QL / 64) * (NH * 64 / 32);
constexpr size_t WS_END = WS_SLZ + 4 * MiB;
static_assert(WS_END <= 256 * MiB, "workspace map exceeds 256 MiB");
static_assert((size_t)MROWS * ZAW * 2 <= 32 * MiB && (size_t)MROWS * DFF * 2 <= 100 * MiB - 6 * MiB, "arena");

__device__ __forceinline__ unsigned cvt_pk_bf16(float lo, float hi) { unsigned r; asm volatile("v_cvt_pk_bf16_f32 %0, %1, %2" : "=v"(r) : "v"(lo), "v"(hi)); return r; }
__device__ __forceinline__ float bf2f(unsigned short u) { return __uint_as_float((unsigned)u << 16); }
__device__ __forceinline__ float bflo(unsigned u) { return __uint_as_float(u << 16); }
__device__ __forceinline__ float bfhi(unsigned u) { return __uint_as_float(u & 0xffff0000u); }
__device__ __forceinline__ float wave_sum(float v) {
#pragma unroll
    for (int o = 1; o < 64; o <<= 1) v += __shfl_xor(v, o);
    return v;
}
__device__ __forceinline__ float sigmoidf_(float x) { return __builtin_amdgcn_rcpf(1.f + __builtin_amdgcn_exp2f(x * -1.4426950408889634f)); }

#ifndef USE_WT_STORES
#define USE_WT_STORES 1
#endif
__device__ __forceinline__ void st16(void* p, u32x4 v) {
#if USE_WT_STORES
    asm volatile("global_store_dwordx4 %0, %1, off sc1\n\ts_nop 1" :: "v"((__attribute__((address_space(1))) void*)p), "v"(v) : "memory");
#else
    *(u32x4*)p = v;
#endif
}
struct Args { const float* in[23]; float* out; unsigned char* ws; int ph_lo, ph_hi; };
typedef const __attribute__((address_space(4))) Args* KArgs;
__device__ __forceinline__ KArgs kargs() { KArgs p = (KArgs)__builtin_amdgcn_kernarg_segment_ptr(); asm volatile("" : "+s"(p)); return p; }
typedef __attribute__((address_space(1))) unsigned char* gws_t;
typedef __attribute__((address_space(1))) float* gout_t;
struct Ctx {
    gout_t out; gws_t ws;
    int tid, lane, wave, G, bid;
    __device__ __forceinline__ const float* in(int i) const { return kargs()->in[i]; }
};
__device__ __forceinline__ float* xs_row(const Ctx& C, int r) { return r < NCTX ? (float*)(C.ws + WS_XC) + (size_t)r * DM : (float*)(C.out + (size_t)(r - NCTX) * DM); }
__device__ __forceinline__ const float* xin_row(const Ctx& C, int r) { return r < NCTX ? C.in(2) + (size_t)r * DM : C.in(0) + (size_t)(r - NCTX) * DM; }
__device__ __forceinline__ int mod_slot(int r) { return r < NCTX ? 4 : (r - NCTX) / SEQ; }
__device__ __forceinline__ int key_index(int r) { return r < NCTX ? (r / CTX) * KPB + (r % CTX) : ((r - NCTX) / SEQ) * KPB + CTX + (r - NCTX) % SEQ; }

constexpr int BM = 256, NXCD = 8, WGM = 8;
struct Unit { int pm, pn, koff, ks; };
template <int LDA, int LDB, int KK> struct Gemm { const bf16_t* A; const bf16_t* Bt; static constexpr int lda = LDA, ldb = LDB, K = KK; };
struct StaticOrder {
    int nM, nN, nwg, G, c, pm0;
    __device__ void init(int nM_, int nN_, int G_, int c_, int pm0_ = 0) { nM = nM_; nN = nN_; nwg = nM * nN; G = G_; c = c_; pm0 = pm0_; }
    __device__ bool next(int i, Unit& u) const {
        const long L = (long)i * G + c; if (L >= nwg) return false;
        int wgid = (int)L; { const int q = nwg / NXCD, r = nwg % NXCD, xcd = wgid % NXCD, off = wgid / NXCD; wgid = (xcd < r ? xcd * (q + 1) : r * (q + 1) + (xcd - r) * q) + off; }
        const int nig = WGM * nN, gid = wgid / nig, fm = gid * WGM, gsz = (nM - fm) < WGM ? (nM - fm) : WGM;
        u.pm = pm0 + fm + ((wgid % nig) % gsz); u.pn = (wgid % nig) / gsz; u.koff = 0; u.ks = 0; return true;
    }
    __device__ __forceinline__ void a_ready(const Unit&) const {}
    __device__ __forceinline__ void done(const Unit&) const {}
};

struct SplitOrder {
    int nN, NS, KS, nwg, G, c, pm0, pn0;
    __device__ void init(int nM_, int nN_, int NS_, int KS_, int G_, int c_, int pm0_, int pn0_) { nN = nN_; NS = NS_; KS = KS_; nwg = nM_ * nN_ * NS_; G = G_; c = c_; pm0 = pm0_; pn0 = pn0_; }
    __device__ bool next(int i, Unit& u) const {
        const int L = i * G + c; if (L >= nwg) return false;
        const int ks = L % NS, t = L / NS; u.pn = pn0 + t % nN; u.pm = pm0 + t / nN; u.koff = ks * KS; u.ks = ks; return true;
    }
    __device__ __forceinline__ void a_ready(const Unit&) const {}
    __device__ __forceinline__ void done(const Unit&) const {}
};

#define EPI_LOOP_ROWS for (int ai = AI_LO; ai < AI_HI; ++ai) _Pragma("unroll") for (int m = 0; m < 4; ++m)

struct EpiZ {
    static constexpr bool PERM = true, AFTER_DRAIN = false;
    bf16_t* ZA; bf16_t* G0; bf16_t* G1;
    template <int AI_LO = 0, int AI_HI = 2> __device__ __forceinline__ void run(const f32x4 (&acc)[2][2][4][2], const Unit& u, int wr, int wc, int fr, int fq) const {
#pragma unroll
        EPI_LOOP_ROWS { const int row = u.pm * BM + ai * 128 + wr * 64 + m * 16 + fr;
#pragma unroll
            for (int bj = 0; bj < 2; ++bj) { const int c0 = u.pn * BM + bj * 128 + wc * 32 + 8 * fq; f32x4 v0 = acc[ai][bj][m][0], v1 = acc[ai][bj][m][1];
                bf16_t* dst;
                if (c0 < ZAW) dst = ZA + (size_t)row * ZAW + c0;
                else if (c0 < DIN) { const bool g1 = c0 >= OFF_GATE + DM; dst = (g1 ? G1 + (c0 - OFF_GATE - DM) : G0 + (c0 - OFF_GATE)) + (size_t)row * DM;
#pragma unroll
                    for (int i = 0; i < 4; ++i) { v0[i] = sigmoidf_(v0[i]); v1[i] = sigmoidf_(v1[i]); } }
                else continue;
                u32x4 w; w.x = cvt_pk_bf16(v0[0], v0[1]); w.y = cvt_pk_bf16(v0[2], v0[3]); w.z = cvt_pk_bf16(v1[0], v1[1]); w.w = cvt_pk_bf16(v1[2], v1[3]);
                st16(dst, w); }
            __builtin_amdgcn_sched_barrier(0); }
    }
};
template <int MODE, int LDC = DM> struct EpiN {
    static constexpr bool PERM = true, AFTER_DRAIN = false;
    bf16_t* O; const bf16_t* G; const bf16_t* T;
    template <int AI_LO = 0, int AI_HI = 2> __device__ __forceinline__ void run(const f32x4 (&acc)[2][2][4][2], const Unit& u, int wr, int wc, int fr, int fq) const {
        constexpr int NIT = (AI_HI - AI_LO) * 4;
        const int row0 = u.pm * BM + wr * 64 + fr, colb = u.pn * BM + wc * 32 + 8 * fq;
        u32x4 gb[2][2], tb[2][2];
        auto ld = [&](int it, int buf) { const int ai = AI_LO + it / 4, m = it % 4; const size_t off = (size_t)(row0 + ai * 128 + m * 16) * LDC + colb;
            if (MODE == 1) { gb[buf][0] = __builtin_nontemporal_load((const u32x4*)(O + off)); gb[buf][1] = __builtin_nontemporal_load((const u32x4*)(O + off + 128)); }
            if (MODE == 2) { gb[buf][0] = __builtin_nontemporal_load((const u32x4*)(G + off)); gb[buf][1] = __builtin_nontemporal_load((const u32x4*)(G + off + 128)); tb[buf][0] = __builtin_nontemporal_load((const u32x4*)(T + off)); tb[buf][1] = __builtin_nontemporal_load((const u32x4*)(T + off + 128)); } };
        if (MODE != 0) ld(0, 0);
#pragma unroll
        for (int it = 0; it < NIT; ++it) { const int ai = AI_LO + it / 4, m = it % 4, buf = it & 1;
            if (MODE != 0 && it + 1 < NIT) ld(it + 1, buf ^ 1);
#pragma unroll
            for (int bj = 0; bj < 2; ++bj) { const size_t off = (size_t)(row0 + ai * 128 + m * 16) * LDC + colb + bj * 128;
                f32x4 v0 = acc[ai][bj][m][0], v1 = acc[ai][bj][m][1];
                if (MODE == 1) { const u32x4 g = gb[buf][bj];
                    v0[0] *= bflo(g.x); v0[1] *= bfhi(g.x); v0[2] *= bflo(g.y); v0[3] *= bfhi(g.y); v1[0] *= bflo(g.z); v1[1] *= bfhi(g.z); v1[2] *= bflo(g.w); v1[3] *= bfhi(g.w); }
                if (MODE == 2) { const u32x4 g = gb[buf][bj]; const u32x4 t = tb[buf][bj];
                    v0[0] = v0[0] * bflo(g.x) + bflo(t.x); v0[1] = v0[1] * bfhi(g.x) + bfhi(t.x); v0[2] = v0[2] * bflo(g.y) + bflo(t.y); v0[3] = v0[3] * bfhi(g.y) + bfhi(t.y);
                    v1[0] = v1[0] * bflo(g.z) + bflo(t.z); v1[1] = v1[1] * bfhi(g.z) + bfhi(t.z); v1[2] = v1[2] * bflo(g.w) + bflo(t.w); v1[3] = v1[3] * bfhi(g.w) + bfhi(t.w); }
                u32x4 w; w.x = cvt_pk_bf16(v0[0], v0[1]); w.y = cvt_pk_bf16(v0[2], v0[3]); w.z = cvt_pk_bf16(v1[0], v1[1]); w.w = cvt_pk_bf16(v1[2], v1[3]);
                st16(O + off, w); }
            __builtin_amdgcn_sched_barrier(0); }
    }
};
template <int LD, int ROWS, bool F32> struct EpiSlab {
    static constexpr bool PERM = true, AFTER_DRAIN = false;
    void* SL; int col0;
    template <int AI_LO = 0, int AI_HI = 2> __device__ __forceinline__ void run(const f32x4 (&acc)[2][2][4][2], const Unit& u, int wr, int wc, int fr, int fq) const {
#pragma unroll
        EPI_LOOP_ROWS { const int row = u.pm * BM + ai * 128 + wr * 64 + m * 16 + fr;
#pragma unroll
            for (int bj = 0; bj < 2; ++bj) { const int c0 = u.pn * BM + bj * 128 + wc * 32 + 8 * fq - col0; const size_t off = ((size_t)u.ks * ROWS + row) * LD + c0;
                const f32x4 v0 = acc[ai][bj][m][0], v1 = acc[ai][bj][m][1];
                if (F32) { *(f32x4*)((float*)SL + off) = v0; *(f32x4*)((float*)SL + off + 4) = v1; }
                else { u32x4 w; w.x = cvt_pk_bf16(v0[0], v0[1]); w.y = cvt_pk_bf16(v0[2], v0[3]); w.z = cvt_pk_bf16(v1[0], v1[1]); w.w = cvt_pk_bf16(v1[2], v1[3]); st16((bf16_t*)SL + off, w); } } }
    }
};
struct EpiGU {
    static constexpr bool PERM = true, AFTER_DRAIN = false;
    bf16_t* ACT;
    template <int AI_LO = 0, int AI_HI = 2> __device__ __forceinline__ void run(const f32x4 (&acc)[2][2][4][2], const Unit& u, int wr, int wc, int fr, int fq) const {
#pragma unroll
        EPI_LOOP_ROWS { const int row = u.pm * BM + ai * 128 + wr * 64 + m * 16 + fr; const int c0 = u.pn * 128 + wc * 32 + 8 * fq;
            f32x4 g0 = acc[ai][0][m][0], g1 = acc[ai][0][m][1]; const f32x4 u0 = acc[ai][1][m][0], u1 = acc[ai][1][m][1];
#pragma unroll
            for (int i = 0; i < 4; ++i) { g0[i] = g0[i] * sigmoidf_(g0[i]) * u0[i]; g1[i] = g1[i] * sigmoidf_(g1[i]) * u1[i]; }
            u32x4 w; w.x = cvt_pk_bf16(g0[0], g0[1]); w.y = cvt_pk_bf16(g0[2], g0[3]); w.z = cvt_pk_bf16(g1[0], g1[1]); w.w = cvt_pk_bf16(g1[2], g1[3]);
            st16(ACT + (size_t)row * DFF + c0, w);
            __builtin_amdgcn_sched_barrier(0); }
    }
};

template <int AI, class Epi, class GemmT>
__device__ __forceinline__ void gemm_simple_half(const GemmT& g, const Unit& u, const Epi& E, int wr, int wc, int fr, int fq) {
    f32x4 acc[2][2][4][2];
#pragma unroll
    for (int b = 0; b < 2; ++b)
#pragma unroll
        for (int m = 0; m < 4; ++m)
#pragma unroll
            for (int n = 0; n < 2; ++n) acc[AI][b][m][n] = (f32x4){0.f, 0.f, 0.f, 0.f};
    const bf16_t* Ab = g.A + (size_t)(u.pm * BM + AI * 128 + wr * 64 + fr) * g.lda + u.koff;
    const bf16_t* Bb = g.Bt + (size_t)(u.pn * BM + wc * 32 + 8 * fq) * g.ldb + u.koff;
    for (int k0 = 0; k0 < g.K; k0 += 4) {
        float af[4][4];
#pragma unroll
        for (int m = 0; m < 4; ++m) { const u32x2 a = *(const u32x2*)(Ab + (size_t)(m * 16) * g.lda + k0);
            af[m][0] = bflo(a.x); af[m][1] = bfhi(a.x); af[m][2] = bflo(a.y); af[m][3] = bfhi(a.y); }
#pragma unroll
        for (int bj = 0; bj < 2; ++bj)
#pragma unroll
            for (int n = 0; n < 2; ++n)
#pragma unroll
                for (int i = 0; i < 4; ++i) { const u32x2 b = *(const u32x2*)(Bb + (size_t)(bj * 128 + 4 * n + i) * g.ldb + k0);
                    float bf[4]; bf[0] = bflo(b.x); bf[1] = bfhi(b.x); bf[2] = bflo(b.y); bf[3] = bfhi(b.y);
#pragma unroll
                    for (int m = 0; m < 4; ++m) { float sacc = acc[AI][bj][m][n][i];
#pragma unroll
                        for (int k = 0; k < 4; ++k) sacc += af[m][k] * bf[k];
                        acc[AI][bj][m][n][i] = sacc; } }
    }
    E.template run<AI, AI + 1>(acc, u, wr, wc, fr, fq);
}
template <class Epi, class Sched, class GemmT>
__device__ __forceinline__ void gemm_simple(const GemmT g, const Sched& S, const Epi& E) {
    const int tid = threadIdx.x, wid = tid >> 6, lane = tid & 63, wr = wid >> 2, wc = wid & 3, fr = lane & 15, fq = lane >> 4;
    Unit u;
    for (int it = 0; S.next(it, u); ++it) { gemm_simple_half<0, Epi, GemmT>(g, u, E, wr, wc, fr, fq); gemm_simple_half<1, Epi, GemmT>(g, u, E, wr, wc, fr, fq); }
}

#define PG8_LAS __attribute__((address_space(3)))
constexpr int BK = 64, HALF = 128, HTB = HALF * BK * 2  , STAGE_BYTES = 8 * HTB;
__host__ __device__ __forceinline__ int lds_byte(int r, int c) { const int st = (r >> 4) * 2 + (c >> 5), rr = r & 15, cc = c & 31, ob = rr * 64 + cc * 2; return st * 1024 + (ob ^ (((ob >> 9) & 1) << 5)); }
__host__ __device__ __forceinline__ void stage_rc(int b, int& R, int& C) { const int st = b / 1024, sb = b % 1024, swz = sb ^ (((sb >> 9) & 1) << 5); R = (st >> 1) * 16 + swz / 64; C = (st & 1) * 32 + (swz % 64) / 2; }
__host__ __device__ __forceinline__ int perm32(int rho) { const int n = rho >> 4, i = rho & 15; return 8 * (i >> 2) + 4 * n + (i & 3); }
template <class Epi, class Sched, bool ALIGN_EPI, bool SP2, class GemmT>
__device__ __forceinline__ void gemm_phase(PG8_LAS unsigned char* lds, const GemmT g, const Sched& S, const Epi& E) {
    int tid_l = threadIdx.x; asm volatile("" : "+v"(tid_l));
    const int tid = tid_l, wid = __builtin_amdgcn_readfirstlane(tid >> 6), lane = tid & 63, wr = wid >> 2, wc = wid & 3, fr = lane & 15, fq = lane >> 4;
    constexpr int K = GemmT::K, nt = K / BK; constexpr int lda = GemmT::lda, ldb = GemmT::ldb;
    unsigned voffA[2], voffB[2];
#pragma unroll
    for (int i = 0; i < 2; ++i) { int R, C; stage_rc(tid * 16 + i * 8192, R, C); const int Rb = Epi::PERM ? ((R & ~31) + perm32(R & 31)) : R;
        voffA[i] = (unsigned)(R * lda + C) * 2u; voffB[i] = (unsigned)(Rb * ldb + C) * 2u; }
    const size_t kstep = (size_t)(BK * 2);
    const size_t hstepA = (size_t)HALF * lda * 2, hstepB = (size_t)HALF * ldb * 2;
    const size_t tstepA = 2 * hstepA, tstepB = 2 * hstepB;
    const unsigned ldsw = (unsigned)wid * 1024u;
    const int aoff = lds_byte(wr * 64 + fr, fq * 8), boff = lds_byte(wc * 32 + fr, fq * 8);
#define PG8_SA(b, h) (((b) * 2 + (h)) * HTB)
#define PG8_SB(b, h) ((4 + (b) * 2 + (h)) * HTB)
#define PG8_STAGE(bufoff, gbase, voff) do { _Pragma("unroll") for (int _i = 0; _i < 2; ++_i) { unsigned _o = (voff)[_i]; asm volatile("" : "+v"(_o)); \
        __builtin_amdgcn_global_load_lds((const unsigned*)((const char*)(gbase) + _o), (PG8_LAS unsigned*)(lds + (bufoff) + ldsw + _i * 8192), 16, 0, 0); } } while (0)
#define PG8_LDA(dst, b, h) do { _Pragma("unroll") for (int m = 0; m < 4; ++m) _Pragma("unroll") for (int k = 0; k < 2; ++k) dst[m][k] = *(const PG8_LAS bf16x8*)(lds + PG8_SA(b, h) + aoff + m * 2048 + k * 1024); } while (0)
#define PG8_LDB(dst, b, h) do { _Pragma("unroll") for (int n = 0; n < 2; ++n) _Pragma("unroll") for (int k = 0; k < 2; ++k) dst[n][k] = *(const PG8_LAS bf16x8*)(lds + PG8_SB(b, h) + boff + n * 2048 + k * 1024); } while (0)
#define PG8_MMA(ai, bj, At, Bt) do { __builtin_amdgcn_s_setprio(1); _Pragma("unroll") for (int m = 0; m < 4; ++m) _Pragma("unroll") for (int n = 0; n < 2; ++n) _Pragma("unroll") for (int k = 0; k < 2; ++k) \
        acc[ai][bj][m][n] = __builtin_amdgcn_mfma_f32_16x16x32_bf16(Bt[n][k], At[m][k], acc[ai][bj][m][n], 0, 0, 0); __builtin_amdgcn_s_setprio(0); } while (0)
#define PG8_WAIT_V(n) asm volatile("s_waitcnt vmcnt(" #n ")" ::: "memory")
#define PG8_WAIT_L(n) asm volatile("s_waitcnt lgkmcnt(" #n ")" ::: "memory")
#define PG8_BAR __builtin_amdgcn_s_barrier()
#define PG8_SCHED __builtin_amdgcn_sched_barrier(0)
    Unit cur, nxt; int ui = 0;
    if (!S.next(0, cur)) return;
    f32x4 acc[2][2][4][2];
#pragma unroll
    for (int a = 0; a < 2; ++a)
#pragma unroll
        for (int b = 0; b < 2; ++b)
#pragma unroll
            for (int m = 0; m < 4; ++m)
#pragma unroll
                for (int n = 0; n < 2; ++n) acc[a][b][m][n] = (f32x4){0.f, 0.f, 0.f, 0.f};
    bf16x8 At[4][2], B0[2][2], B1[2][2];
    const char* cA = (const char*)g.A + (size_t)cur.pm * tstepA + (size_t)cur.koff * 2; const char* cB = (const char*)g.Bt + (size_t)cur.pn * tstepB + (size_t)cur.koff * 2;
    S.a_ready(cur);
    if constexpr (SP2) {
        PG8_STAGE(PG8_SB(0, 0), cB, voffB); PG8_STAGE(PG8_SB(0, 1), cB + hstepB, voffB); PG8_STAGE(PG8_SA(0, 0), cA, voffA); PG8_STAGE(PG8_SA(0, 1), cA + hstepA, voffA);
        if (wr == 1) PG8_BAR;
        PG8_WAIT_V(2); PG8_BAR;
        PG8_STAGE(PG8_SB(1, 0), cB + kstep, voffB); PG8_STAGE(PG8_SA(1, 0), cA + kstep, voffA); PG8_STAGE(PG8_SB(1, 1), cB + hstepB + kstep, voffB);
        PG8_WAIT_V(6); PG8_BAR;
    } else {
        PG8_STAGE(PG8_SB(0, 0), cB, voffB); PG8_STAGE(PG8_SA(0, 0), cA, voffA); PG8_STAGE(PG8_SB(0, 1), cB + hstepB, voffB); PG8_STAGE(PG8_SA(0, 1), cA + hstepA, voffA);
        if (wr == 1) PG8_BAR;
        PG8_WAIT_V(4); PG8_BAR;
        PG8_STAGE(PG8_SB(1, 0), cB + kstep, voffB); PG8_STAGE(PG8_SA(1, 0), cA + kstep, voffA); PG8_STAGE(PG8_SB(1, 1), cB + hstepB + kstep, voffB);
        PG8_WAIT_V(6); PG8_BAR;
    }
    for (;;) {
        const bool has_next = S.next(ui + 1, nxt);
        const char* nA = has_next ? (const char*)g.A + (size_t)nxt.pm * tstepA + (size_t)nxt.koff * 2 : cA; const char* nB = has_next ? (const char*)g.Bt + (size_t)nxt.pn * tstepB + (size_t)nxt.koff * 2 : cB;
#pragma nounroll
        for (int t = 0; t < nt; t += 2) {
            const bool last = (t == nt - 2);
            const char* a1 = cA + (size_t)(t + 1) * kstep;
            const char* a2 = last ? nA : cA + (size_t)(t + 2) * kstep; const char* b2 = last ? nB : cB + (size_t)(t + 2) * kstep;
            const char* a3 = a2 + kstep; const char* b3 = b2 + kstep;
            if (last && has_next) S.a_ready(nxt);
            if constexpr (SP2) {
            PG8_LDB(B0, 0, 0); PG8_LDB(B1, 0, 1); PG8_SCHED; PG8_LDA(At, 0, 0); PG8_STAGE(PG8_SA(1, 1), a1 + hstepA, voffA);
            PG8_WAIT_V(8); PG8_WAIT_L(0); PG8_BAR; PG8_MMA(0, 0, At, B0); PG8_MMA(0, 1, At, B1); PG8_BAR; PG8_SCHED;
            PG8_LDA(At, 0, 1); PG8_STAGE(PG8_SB(0, 0), b2, voffB); PG8_STAGE(PG8_SB(0, 1), b2 + hstepB, voffB); PG8_STAGE(PG8_SA(0, 0), a2, voffA);
            PG8_WAIT_V(8); PG8_WAIT_L(0); PG8_BAR; PG8_MMA(1, 0, At, B0); PG8_MMA(1, 1, At, B1); PG8_BAR; PG8_SCHED;
            PG8_LDB(B0, 1, 0); PG8_LDB(B1, 1, 1); PG8_SCHED; PG8_LDA(At, 1, 0); PG8_STAGE(PG8_SA(0, 1), a2 + hstepA, voffA);
            PG8_WAIT_V(8); PG8_WAIT_L(0); PG8_BAR; PG8_MMA(0, 0, At, B0); PG8_MMA(0, 1, At, B1); PG8_BAR; PG8_SCHED;
            PG8_LDA(At, 1, 1); PG8_STAGE(PG8_SB(1, 0), b3, voffB); PG8_STAGE(PG8_SB(1, 1), b3 + hstepB, voffB); PG8_STAGE(PG8_SA(1, 0), a3, voffA);
            PG8_WAIT_V(8); PG8_WAIT_L(0); PG8_BAR; PG8_MMA(1, 0, At, B0); PG8_MMA(1, 1, At, B1); PG8_BAR; PG8_SCHED;
            } else {
            PG8_LDB(B0, 0, 0); PG8_SCHED; PG8_LDA(At, 0, 0); PG8_STAGE(PG8_SA(1, 1), a1 + hstepA, voffA);
            PG8_WAIT_L(8); PG8_BAR; PG8_WAIT_L(0); PG8_MMA(0, 0, At, B0); PG8_BAR; PG8_SCHED;
            PG8_LDB(B1, 0, 1); PG8_STAGE(PG8_SB(0, 0), b2, voffB);
            PG8_BAR; PG8_WAIT_L(0); PG8_MMA(0, 1, At, B1); PG8_BAR;
            PG8_LDA(At, 0, 1); PG8_STAGE(PG8_SA(0, 0), a2, voffA);
            PG8_BAR; PG8_WAIT_L(0); PG8_MMA(1, 0, At, B0); PG8_BAR; PG8_SCHED;
            PG8_STAGE(PG8_SB(0, 1), b2 + hstepB, voffB);
            PG8_WAIT_V(6); PG8_BAR; PG8_MMA(1, 1, At, B1); PG8_BAR;
            PG8_LDB(B0, 1, 0); PG8_SCHED; PG8_LDA(At, 1, 0); PG8_STAGE(PG8_SA(0, 1), a2 + hstepA, voffA);
            PG8_WAIT_L(8); PG8_BAR; PG8_WAIT_L(0); PG8_MMA(0, 0, At, B0); PG8_BAR; PG8_SCHED;
            PG8_LDB(B1, 1, 1); PG8_STAGE(PG8_SB(1, 0), b3, voffB);
            PG8_BAR; PG8_WAIT_L(0); PG8_MMA(0, 1, At, B1); PG8_BAR;
            PG8_LDA(At, 1, 1); PG8_STAGE(PG8_SA(1, 0), a3, voffA);
            PG8_BAR; PG8_WAIT_L(0); PG8_MMA(1, 0, At, B0); PG8_BAR; PG8_SCHED;
            PG8_STAGE(PG8_SB(1, 1), b3 + hstepB, voffB);
            PG8_WAIT_V(6); PG8_BAR; PG8_MMA(1, 1, At, B1); PG8_BAR;
            }
        }
        if constexpr (ALIGN_EPI) { if (wr == 0) PG8_BAR; }
        if constexpr (!Epi::AFTER_DRAIN) { E.template run<0, 2>(acc, cur, wr, wc, fr, fq); S.done(cur); }
        if (!has_next) break;
#pragma unroll
        for (int a = 0; a < 2; ++a)
#pragma unroll
            for (int b = 0; b < 2; ++b)
#pragma unroll
                for (int m = 0; m < 4; ++m)
#pragma unroll
                    for (int n = 0; n < 2; ++n) acc[a][b][m][n] = (f32x4){0.f, 0.f, 0.f, 0.f};
        cur = nxt; cA = nA; cB = nB; ++ui;
        if constexpr (ALIGN_EPI) { if (wr == 1) PG8_BAR; }
    }
    PG8_WAIT_V(0);
    if constexpr (!ALIGN_EPI) { if (wr == 0) PG8_BAR; }
    PG8_BAR;
    if constexpr (Epi::AFTER_DRAIN) { E.fused(acc, cur, wr, wc, fr, fq, lds, wid, lane); S.done(cur); }
#undef PG8_SA
#undef PG8_SB
#undef PG8_STAGE
#undef PG8_LDA
#undef PG8_LDB
#undef PG8_MMA
#undef PG8_WAIT_V
#undef PG8_WAIT_L
#undef PG8_BAR
#undef PG8_SCHED
}

template <class Epi, class GemmT, class Sched>
__device__ __forceinline__ void gemm_phase_any(unsigned char* lds, const GemmT g, const Sched& S, const Epi& E) {
#if USE_MFMA_GEMM
    gemm_phase<Epi, Sched, GEMM_ALIGN, GEMM_SP2, GemmT>((PG8_LAS unsigned char*)lds, g, S, E);
#else
    gemm_simple<Epi, Sched, GemmT>(g, S, E);
#endif
}

__device__ __forceinline__ void q_fixup(float (&v)[8], int row, int col0, float rs, const f32x2* tab) {
#pragma unroll
    for (int i = 0; i < 8; ++i) v[i] *= rs;
    if (col0 >= 128 && row >= NCTX) { const int tpos = (row - NCTX) & (SEQ - 1), p0 = (col0 - 128) >> 1, axis = p0 >> 4, f0 = p0 & 15;
        const f32x2* tb = tab + (axis ? (tpos & 63) : (tpos >> 6)) * 16 + f0;
#pragma unroll
        for (int i = 0; i < 4; ++i) { const f32x2 t = tb[i]; const float a = v[2 * i], b = v[2 * i + 1]; v[2 * i] = a * t.x - b * t.y; v[2 * i + 1] = a * t.y + b * t.x; } }
}
__device__ __forceinline__ void attn_simple_unit(unsigned char* lds, const bf16_t* Q, const bf16_t* KL, bf16_t* O, const float* rstdq, const f32x2* tab, int qrow0, int h, int key0, int nkeys) {
    bf16_t* Qs = (bf16_t*)lds;
    float* Ks = (float*)(lds + 256 * 194 * 2);
    int t_l = threadIdx.x; asm volatile("" : "+v"(t_l));
    const int t = t_l, row = t >> 1, half = t & 1;
    __syncthreads();
    for (int i = t; i < 256 * 24; i += NTHREADS) { const int r = i / 24, c0 = (i % 24) * 8; const u32x4 q = *(const u32x4*)(Q + (size_t)(qrow0 + r) * QW + h * 192 + c0);
        float v[8] = {bflo(q.x), bfhi(q.x), bflo(q.y), bfhi(q.y), bflo(q.z), bfhi(q.z), bflo(q.w), bfhi(q.w)};
        q_fixup(v, qrow0 + r, c0, rstdq[qrow0 + r], tab);
#pragma unroll
        for (int k = 0; k < 8; k += 2) *(unsigned*)(Qs + r * 194 + c0 + k) = cvt_pk_bf16(v[k], v[k + 1]); }
    float m = -1e30f, l = 0.f, acc[64];
#pragma unroll
    for (int d = 0; d < 64; ++d) acc[d] = 0.f;
    for (int j0 = 0; j0 < nkeys; j0 += 16) {
        __syncthreads();
        for (int i = t; i < 16 * 192; i += NTHREADS) { const int j = i / 192, d = i % 192; Ks[j * 193 + d] = bf2f(KL[(size_t)(key0 + j0 + j) * KW + d]); }
        __syncthreads();
        float s[16];
#pragma unroll
        for (int j = 0; j < 16; ++j) s[j] = 0.f;
        for (int d = 0; d < 192; ++d) { const float qv = bf2f(Qs[row * 194 + d]);
#pragma unroll
            for (int j = 0; j < 16; ++j) s[j] += qv * Ks[j * 193 + d]; }
        float mx = s[0];
#pragma unroll
        for (int j = 1; j < 16; ++j) mx = fmaxf(mx, s[j]);
        const float mn = fmaxf(m, mx), alpha = exp2f(m - mn); m = mn;
        float ps = 0.f;
#pragma unroll
        for (int j = 0; j < 16; ++j) { s[j] = exp2f(s[j] - mn); ps += s[j]; }
        l = l * alpha + ps;
#pragma unroll
        for (int d = 0; d < 64; ++d) acc[d] *= alpha;
#pragma unroll 4
        for (int j = 0; j < 16; ++j) { const float p = bf2f((unsigned short)(cvt_pk_bf16(s[j], 0.f) & 0xffffu));
#pragma unroll
            for (int d = 0; d < 64; ++d) acc[d] += p * Ks[j * 193 + half * 64 + d]; }
    }
    const float rl = 1.f / l;
    bf16_t* o = O + (size_t)(qrow0 + row) * DM + h * 128 + half * 64;
#pragma unroll
    for (int d = 0; d < 64; d += 8) { u32x4 w; w.x = cvt_pk_bf16(acc[d] * rl, acc[d + 1] * rl); w.y = cvt_pk_bf16(acc[d + 2] * rl, acc[d + 3] * rl); w.z = cvt_pk_bf16(acc[d + 4] * rl, acc[d + 5] * rl); w.w = cvt_pk_bf16(acc[d + 6] * rl, acc[d + 7] * rl);
        *(u32x4*)(o + d) = w; }
}


namespace attn {
using s16x4 = __attribute__((ext_vector_type(4))) short;
#ifndef ATTN_NBUF
#define ATTN_NBUF 2
#endif
constexpr int NBUF = ATTN_NBUF;
constexpr int KROW = 400, SHM_V = 64 * 128 * 2, SHM_K = 64 * KROW, OFF_K = NBUF * SHM_V, OFF_WS = OFF_K + NBUF * SHM_K, LDS_NEED = OFF_WS + NWAVES * 64 * 4;
static_assert(LDS_NEED <= 131072, "attention LDS");
constexpr float THR2 = 8.f * 1.4426950408889634f;
#define SBAR() __builtin_amdgcn_sched_barrier(0)
__device__ __forceinline__ int crow(int r, int hi) { return (r & 3) + 8 * (r >> 2) + 4 * hi; }
template <int ABL> __device__ __forceinline__ void partialSM(f32x16& p0, f32x16& p1, float& m_reg, float& mn, float& alpha) {
  float pmax = p0[0]; for (int r = 1; r < 16; ++r) pmax = fmaxf(pmax, p0[r]); for (int r = 0; r < 16; ++r) pmax = fmaxf(pmax, p1[r]);
  { auto rr = __builtin_amdgcn_permlane32_swap(__float_as_uint(pmax), __float_as_uint(pmax), false, false);
    pmax = fmaxf(__uint_as_float(rr[0]), __uint_as_float(rr[1])); }
  if (__builtin_expect(__all(pmax - m_reg <= THR2), 1)) { mn = m_reg; alpha = 1.f; }
  else { mn = fmaxf(m_reg, pmax); alpha = __builtin_amdgcn_exp2f(m_reg - mn); m_reg = mn; }
  for (int r = 0; r < 16; ++r) p0[r] = p0[r] - mn; for (int r = 0; r < 16; ++r) p1[r] = p1[r] - mn;
  if (!(ABL & 1)) for (int r = 0; r < 16; ++r) p0[r] = __builtin_amdgcn_exp2f(p0[r]);
}
__device__ __forceinline__ void partialSM_negm(f32x16& p0, f32x16& p1, float& m_reg, float& alpha, f32x16& negm, bool first) {
  float pmax = p0[0]; for (int r = 1; r < 16; ++r) pmax = fmaxf(pmax, p0[r]); for (int r = 0; r < 16; ++r) pmax = fmaxf(pmax, p1[r]);
  { auto rr = __builtin_amdgcn_permlane32_swap(__float_as_uint(pmax), __float_as_uint(pmax), false, false);
    pmax = fmaxf(__uint_as_float(rr[0]), __uint_as_float(rr[1])); }
  if (__builtin_expect(!first && __all(pmax <= THR2), 1)) { alpha = 1.f; }
  else { const float dl = first ? pmax : fmaxf(pmax, 0.f); alpha = __builtin_amdgcn_exp2f(-fmaxf(dl, 0.f)); m_reg += dl; const float nm = -m_reg;
    for (int r = 0; r < 16; ++r) { p0[r] = p0[r] - dl; p1[r] = p1[r] - dl; negm[r] = nm; } }
  for (int r = 0; r < 16; ++r) p0[r] = __builtin_amdgcn_exp2f(p0[r]);
}
template <int ABL> __device__ __forceinline__ void finishSM(f32x16& p0, f32x16& p1, float alpha, float& l_reg, bf16x8& pa0, bf16x8& pa1, bf16x8& pa2, bf16x8& pa3) {
  if (!(ABL & 1)) for (int r = 0; r < 16; ++r) p1[r] = __builtin_amdgcn_exp2f(p1[r]);
  float ps = 0; for (int r = 0; r < 16; ++r) ps += p0[r]; for (int r = 0; r < 16; ++r) ps += p1[r];
  { auto rr = __builtin_amdgcn_permlane32_swap(__float_as_uint(ps), __float_as_uint(ps), false, false);
    ps = __uint_as_float(rr[0]) + __uint_as_float(rr[1]); }
  l_reg = l_reg * alpha + ps;
#if NATIVE_PV
#define PK4(P, BASE, OUT) do { u32x4 w = {cvt_pk_bf16(P[BASE + 0], P[BASE + 1]), cvt_pk_bf16(P[BASE + 2], P[BASE + 3]), cvt_pk_bf16(P[BASE + 4], P[BASE + 5]), cvt_pk_bf16(P[BASE + 6], P[BASE + 7])}; \
    OUT = *reinterpret_cast<bf16x8*>(&w); } while (0)
#else
#define PK4(P, BASE, OUT) do { unsigned a0 = cvt_pk_bf16(P[BASE + 0], P[BASE + 1]), a1 = cvt_pk_bf16(P[BASE + 2], P[BASE + 3]);   \
    unsigned b0 = cvt_pk_bf16(P[BASE + 4], P[BASE + 5]), b1 = cvt_pk_bf16(P[BASE + 6], P[BASE + 7]);                              \
    auto r0 = __builtin_amdgcn_permlane32_swap(a0, b0, false, false); auto r1 = __builtin_amdgcn_permlane32_swap(a1, b1, false, false); \
    u32x4 w = {r0[0], r1[0], r0[1], r1[1]}; OUT = *reinterpret_cast<bf16x8*>(&w); } while (0)
#endif
  PK4(p0, 0, pa0); PK4(p0, 8, pa1); PK4(p1, 0, pa2); PK4(p1, 8, pa3);
#undef PK4
}
template <int ABL> __device__ __forceinline__ void qkt(f32x16& p0, f32x16& p1, const char* Ks, const bf16x8* qr, int r32, int hi) {
  p0 = f32x16{}; p1 = f32x16{};
  if (ABL & 8) { asm volatile("" : "+v"(p0), "+v"(p1)); return; }
#pragma unroll
  for (int d0 = 0; d0 < 12; ++d0) { const int cb = (d0 * 16 + hi * 8) * 2;
    bf16x8 b0, b1;
    if (ABL & 16) { b0 = qr[(d0 + 1) % 12]; b1 = qr[(d0 + 2) % 12]; }
    else { b0 = *reinterpret_cast<const bf16x8*>(Ks + r32 * KROW + cb); b1 = *reinterpret_cast<const bf16x8*>(Ks + (32 + r32) * KROW + cb); }
    p0 = __builtin_amdgcn_mfma_f32_32x32x16_bf16(b0, qr[d0], p0, 0, 0, 0);
    p1 = __builtin_amdgcn_mfma_f32_32x32x16_bf16(b1, qr[d0], p1, 0, 0, 0); }
}
#ifndef QKD
#define QKD 4
#endif
template <int OFF> __device__ __forceinline__ bf16x8 lds_rd128(int addr) { bf16x8 r; asm volatile("ds_read_b128 %0, %1 offset:%2" : "=&v"(r) : "v"(addr), "i"(OFF) : "memory"); return r; }
template <int N> __device__ __forceinline__ void lgkm_wait() { asm volatile("s_waitcnt lgkmcnt(%0)" :: "i"(N) : "memory"); __builtin_amdgcn_sched_barrier(0); }
template <int D0> __device__ __forceinline__ void qk_step(f32x16& p0, f32x16& p1, bf16x8 (&f0)[12], bf16x8 (&f1)[12], const bf16x8* qr, int ka) {
  if constexpr (D0 + QKD < 12) { f0[D0 + QKD] = lds_rd128<(D0 + QKD) * 32>(ka); f1[D0 + QKD] = lds_rd128<32 * KROW + (D0 + QKD) * 32>(ka); }
  constexpr int AHEAD = (11 - D0) < QKD ? (11 - D0) : QKD;
  lgkm_wait<2 * AHEAD>();
  p0 = __builtin_amdgcn_mfma_f32_32x32x16_bf16(f0[D0], qr[D0], p0, 0, 0, 0);
  p1 = __builtin_amdgcn_mfma_f32_32x32x16_bf16(f1[D0], qr[D0], p1, 0, 0, 0);
  if constexpr (D0 + 1 < 12) qk_step<D0 + 1>(p0, p1, f0, f1, qr, ka);
}
__device__ __forceinline__ void qkt_asm(f32x16& p0, f32x16& p1, const char* Ks, const bf16x8* qr, int r32, int hi) {
  p0 = f32x16{}; p1 = f32x16{};
  const int ka = (int)(uintptr_t)Ks + r32 * KROW + hi * 16;
  bf16x8 f0[12], f1[12];
  f0[0] = lds_rd128<0>(ka); f1[0] = lds_rd128<32 * KROW>(ka);
  if constexpr (QKD > 1) { f0[1] = lds_rd128<32>(ka); f1[1] = lds_rd128<32 * KROW + 32>(ka); }
  if constexpr (QKD > 2) { f0[2] = lds_rd128<64>(ka); f1[2] = lds_rd128<32 * KROW + 64>(ka); }
  if constexpr (QKD > 3) { f0[3] = lds_rd128<96>(ka); f1[3] = lds_rd128<32 * KROW + 96>(ka); }
  if constexpr (QKD > 4) { f0[4] = lds_rd128<128>(ka); f1[4] = lds_rd128<32 * KROW + 128>(ka); }
  if constexpr (QKD > 5) { f0[5] = lds_rd128<160>(ka); f1[5] = lds_rd128<32 * KROW + 160>(ka); }
  qk_step<0>(p0, p1, f0, f1, qr, ka);
}
constexpr int KROW2 = 384, SHM_K2 = 64 * KROW2;
template <int D0> __device__ __forceinline__ void qk_step2(f32x16& p0, f32x16& p1, bf16x8 (&f0)[12], bf16x8 (&f1)[12], const bf16x8* qr, const int (&ka)[4]) {
  if constexpr (D0 + QKD < 12) { constexpr int E = D0 + QKD; f0[E] = lds_rd128<(E >> 2) * 128>(ka[E & 3]); f1[E] = lds_rd128<32 * KROW2 + (E >> 2) * 128>(ka[E & 3]); }
  constexpr int AHEAD = (11 - D0) < QKD ? (11 - D0) : QKD;
  lgkm_wait<2 * AHEAD>();
  p0 = __builtin_amdgcn_mfma_f32_32x32x16_bf16(f0[D0], qr[D0], p0, 0, 0, 0);
  p1 = __builtin_amdgcn_mfma_f32_32x32x16_bf16(f1[D0], qr[D0], p1, 0, 0, 0);
  if constexpr (D0 + 1 < 12) qk_step2<D0 + 1>(p0, p1, f0, f1, qr, ka);
}
__device__ __forceinline__ void qkt_asm2(f32x16& p0, f32x16& p1, int kb, int t, const bf16x8* qr) {
  p0 = f32x16{}; p1 = f32x16{};
  const int ka[4] = {kb + ((0 ^ t) << 5), kb + ((1 ^ t) << 5), kb + ((2 ^ t) << 5), kb + ((3 ^ t) << 5)};
  bf16x8 f0[12], f1[12];
  f0[0] = lds_rd128<0>(ka[0]); f1[0] = lds_rd128<32 * KROW2>(ka[0]);
  if constexpr (QKD > 1) { f0[1] = lds_rd128<0>(ka[1]); f1[1] = lds_rd128<32 * KROW2>(ka[1]); }
  if constexpr (QKD > 2) { f0[2] = lds_rd128<0>(ka[2]); f1[2] = lds_rd128<32 * KROW2>(ka[2]); }
  if constexpr (QKD > 3) { f0[3] = lds_rd128<0>(ka[3]); f1[3] = lds_rd128<32 * KROW2>(ka[3]); }
  static_assert(QKD <= 4, "qkt_asm2 prefetch depth");
  qk_step2<0>(p0, p1, f0, f1, qr, ka);
}
__device__ __forceinline__ int v_st(int k, int c) { const int kk = NATIVE_PV ? k : ((k & ~0xC) | ((k & 4) << 1) | ((k & 8) >> 1)); return ((kk >> 3) * 4 + (c >> 5)) * 512 + ((kk & 7) * 32 + (c & 31)) * 2; }
__device__ __forceinline__ int v_rd_base(int lane) { return ((lane & 3) << 3) | (((lane >> 2) & 3) << 6) | (((lane >> 4) & 1) << 5) | (((lane >> 5) & 1) << 8); }
constexpr int v_rd_off(int d0, int ks, int half) { return d0 * 512 + ks * 4096 + half * 2048; }
template <int OFF> __device__ __forceinline__ s16x4 tr_read(int vb) {
  s16x4 r; asm volatile("ds_read_b64_tr_b16 %0, %1 offset:%2" : "=&v"(r) : "v"(vb), "i"(OFF) : "memory"); return r;
}
template <int D0, int ABL = 0> __device__ __forceinline__ void pv_one(f32x16& od, int vb, bf16x8 pa0, bf16x8 pa1, bf16x8 pa2, bf16x8 pa3) {
  if (ABL & 16) { od = __builtin_amdgcn_mfma_f32_32x32x16_bf16(pa0, pa1, od, 0, 0, 0); od = __builtin_amdgcn_mfma_f32_32x32x16_bf16(pa1, pa2, od, 0, 0, 0); od = __builtin_amdgcn_mfma_f32_32x32x16_bf16(pa2, pa3, od, 0, 0, 0); od = __builtin_amdgcn_mfma_f32_32x32x16_bf16(pa3, pa0, od, 0, 0, 0); return; }
  const s16x4 l0 = tr_read<v_rd_off(D0, 0, 0)>(vb), h0 = tr_read<v_rd_off(D0, 0, 1)>(vb), l1 = tr_read<v_rd_off(D0, 1, 0)>(vb), h1 = tr_read<v_rd_off(D0, 1, 1)>(vb);
  const s16x4 l2 = tr_read<v_rd_off(D0, 2, 0)>(vb), h2 = tr_read<v_rd_off(D0, 2, 1)>(vb), l3 = tr_read<v_rd_off(D0, 3, 0)>(vb), h3 = tr_read<v_rd_off(D0, 3, 1)>(vb);
  asm volatile("s_waitcnt lgkmcnt(0)" ::: "memory"); SBAR();
#define PK(L, H) (bf16x8){L[0], L[1], L[2], L[3], H[0], H[1], H[2], H[3]}
  od = __builtin_amdgcn_mfma_f32_32x32x16_bf16(pa0, PK(l0, h0), od, 0, 0, 0);
  od = __builtin_amdgcn_mfma_f32_32x32x16_bf16(pa1, PK(l1, h1), od, 0, 0, 0);
  od = __builtin_amdgcn_mfma_f32_32x32x16_bf16(pa2, PK(l2, h2), od, 0, 0, 0);
  od = __builtin_amdgcn_mfma_f32_32x32x16_bf16(pa3, PK(l3, h3), od, 0, 0, 0);
#undef PK
}
template <int ABL> __device__ __forceinline__ void pv_d0(f32x16* o, int vb, bf16x8 pa0, bf16x8 pa1, bf16x8 pa2, bf16x8 pa3) {
  if (ABL & 4) { asm volatile("" :: "v"(pa0), "v"(pa1), "v"(pa2), "v"(pa3)); return; }
  pv_one<0, ABL>(o[0], vb, pa0, pa1, pa2, pa3); pv_one<1, ABL>(o[1], vb, pa0, pa1, pa2, pa3); pv_one<2, ABL>(o[2], vb, pa0, pa1, pa2, pa3); pv_one<3, ABL>(o[3], vb, pa0, pa1, pa2, pa3);
}
template <int B> __device__ __forceinline__ void v_rd_blk(s16x4 (&vl)[4][4], s16x4 (&vh)[4][4], int vb) {
  vl[B][0] = tr_read<v_rd_off(B, 0, 0)>(vb); vh[B][0] = tr_read<v_rd_off(B, 0, 1)>(vb); vl[B][1] = tr_read<v_rd_off(B, 1, 0)>(vb); vh[B][1] = tr_read<v_rd_off(B, 1, 1)>(vb);
  vl[B][2] = tr_read<v_rd_off(B, 2, 0)>(vb); vh[B][2] = tr_read<v_rd_off(B, 2, 1)>(vb); vl[B][3] = tr_read<v_rd_off(B, 3, 0)>(vb); vh[B][3] = tr_read<v_rd_off(B, 3, 1)>(vb);
}
template <int B> __device__ __forceinline__ void pv_blk(f32x16& od, const s16x4 (&vl)[4][4], const s16x4 (&vh)[4][4], bf16x8 pa0, bf16x8 pa1, bf16x8 pa2, bf16x8 pa3) {
#define PKV(k) (bf16x8){vl[B][k][0], vl[B][k][1], vl[B][k][2], vl[B][k][3], vh[B][k][0], vh[B][k][1], vh[B][k][2], vh[B][k][3]}
  od = __builtin_amdgcn_mfma_f32_32x32x16_bf16(pa0, PKV(0), od, 0, 0, 0); od = __builtin_amdgcn_mfma_f32_32x32x16_bf16(pa1, PKV(1), od, 0, 0, 0);
  od = __builtin_amdgcn_mfma_f32_32x32x16_bf16(pa2, PKV(2), od, 0, 0, 0); od = __builtin_amdgcn_mfma_f32_32x32x16_bf16(pa3, PKV(3), od, 0, 0, 0);
#undef PKV
}
template <int D> __device__ __forceinline__ void k_rd_blk(bf16x8 (&f0)[12], bf16x8 (&f1)[12], const int (&ka)[4]) { f0[D] = lds_rd128<(D >> 2) * 128>(ka[D & 3]); f1[D] = lds_rd128<32 * KROW2 + (D >> 2) * 128>(ka[D & 3]); }
template <bool PVF, bool QKF>
__device__ __forceinline__ void m_seg(f32x16& p0, f32x16& p1, f32x16* o, bf16x8 pa0, bf16x8 pa1, bf16x8 pa2, bf16x8 pa3, int kb, int kt, int vb, const bf16x8* qr, const f32x16& negm) {
  static_assert(QKD == 4, "m_seg assumes QKD == 4");
  const int ka[4] = {kb + ((0 ^ kt) << 5), kb + ((1 ^ kt) << 5), kb + ((2 ^ kt) << 5), kb + ((3 ^ kt) << 5)};
  bf16x8 f0[12], f1[12]; s16x4 vl[4][4], vh[4][4];
  SBAR();
  if (PVF) { v_rd_blk<0>(vl, vh, vb); v_rd_blk<1>(vl, vh, vb); }
  if (QKF) { k_rd_blk<0>(f0, f1, ka); k_rd_blk<1>(f0, f1, ka); }
  if (PVF) {
    lgkm_wait<8 + (QKF ? 4 : 0)>(); pv_blk<0>(o[0], vl, vh, pa0, pa1, pa2, pa3); v_rd_blk<2>(vl, vh, vb); SBAR();
    lgkm_wait<8 + (QKF ? 4 : 0)>(); pv_blk<1>(o[1], vl, vh, pa0, pa1, pa2, pa3); v_rd_blk<3>(vl, vh, vb); SBAR();
    lgkm_wait<8>(); pv_blk<2>(o[2], vl, vh, pa0, pa1, pa2, pa3); if (QKF) { k_rd_blk<2>(f0, f1, ka); k_rd_blk<3>(f0, f1, ka); } SBAR();
    lgkm_wait<(QKF ? 4 : 0)>(); pv_blk<3>(o[3], vl, vh, pa0, pa1, pa2, pa3); SBAR();
  } else if (QKF) { k_rd_blk<2>(f0, f1, ka); k_rd_blk<3>(f0, f1, ka); }
#if SM_NEGM
  if (QKF) {
    if constexpr (QKD + 0 < 12) { f0[QKD] = lds_rd128<(QKD >> 2) * 128>(ka[QKD & 3]); f1[QKD] = lds_rd128<32 * KROW2 + (QKD >> 2) * 128>(ka[QKD & 3]); }
    lgkm_wait<2 * QKD>();
    p0 = __builtin_amdgcn_mfma_f32_32x32x16_bf16(f0[0], qr[0], negm, 0, 0, 0);
    p1 = __builtin_amdgcn_mfma_f32_32x32x16_bf16(f1[0], qr[0], negm, 0, 0, 0);
    qk_step2<1>(p0, p1, f0, f1, qr, ka); }
#else
  if (QKF) { p0 = f32x16{}; p1 = f32x16{}; qk_step2<0>(p0, p1, f0, f1, qr, ka); }
#endif
}
#ifndef ATTN_SDEPTH
#define ATTN_SDEPTH 2
#endif
constexpr int SDEPTH = ATTN_SDEPTH;
template <int ABL = 0> __device__ __forceinline__ void unit(char* lds, const bf16_t* __restrict__ Qg, const bf16_t* __restrict__ Kb, bf16_t* __restrict__ Og, const float* rstdq, const f32x2* tab,
                                     int qrow0, int h, int nkeys) {
  int tid_l = threadIdx.x; asm volatile("" : "+v"(tid_l));
  const int tid = tid_l, wid = tid >> 6, lane = tid & 63, r32 = lane & 31, hi = lane >> 5;
  char* V_lds = lds; char* K_lds = lds + OFF_K;
  float* ws = (float*)(lds + OFF_WS) + wid * 64; float* li_l = ws; float* al_l = ws + 32;
  float m_reg = -1e30f, l_reg = 0; f32x16 o[4] = {}; bf16x8 qr[12];
  { const int row = qrow0 + wid * 32 + r32; const float rs = rstdq[row]; const bf16_t* Qw = Qg + (size_t)row * QW + h * 192 + hi * 8;
#pragma unroll
    for (int d0 = 0; d0 < 12; ++d0) { const u32x4 q = *(const u32x4*)(Qw + d0 * 16);
      float v[8] = {bflo(q.x), bfhi(q.x), bflo(q.y), bfhi(q.y), bflo(q.z), bfhi(q.z), bflo(q.w), bfhi(q.w)};
      q_fixup(v, row, d0 * 16 + hi * 8, rs, tab);
      u32x4 w = {cvt_pk_bf16(v[0], v[1]), cvt_pk_bf16(v[2], v[3]), cvt_pk_bf16(v[4], v[5]), cvt_pk_bf16(v[6], v[7])}; qr[d0] = *reinterpret_cast<bf16x8*>(&w); } }
  const int sr = tid >> 4, sc = (tid & 15) * 8, vst0 = v_st(sr, sc), vst1 = v_st(32 + sr, sc);
  const int kst0 = sr * KROW + sc * 2, kst1 = (32 + sr) * KROW + sc * 2, rr = tid >> 3, rc = 128 + (tid & 7) * 8, kst2 = rr * KROW + rc * 2;
  const int vb0 = (int)(uintptr_t)V_lds + v_rd_base(lane);
  struct { bf16x8 ks0, ks1, kr; } sr_[SDEPTH];
#define SLOAD(i, k0) do { if ((ABL & 2) && (k0) > 128) break; sr_[i].ks0 = *(const bf16x8*)(Kb + (size_t)((k0) + sr) * KW + sc); sr_[i].ks1 = *(const bf16x8*)(Kb + (size_t)((k0) + 32 + sr) * KW + sc); \
    sr_[i].kr = *(const bf16x8*)(Kb + (size_t)((k0) + rr) * KW + rc); } while (0)
#define SWRITE(b, i) do { if ((ABL & 2) && nowrite) break; *(bf16x8*)(V_lds + (b) * SHM_V + vst0) = sr_[i].ks0; *(bf16x8*)(V_lds + (b) * SHM_V + vst1) = sr_[i].ks1; \
    *(bf16x8*)(K_lds + (b) * SHM_K + kst0) = sr_[i].ks0; *(bf16x8*)(K_lds + (b) * SHM_K + kst1) = sr_[i].ks1; *(bf16x8*)(K_lds + (b) * SHM_K + kst2) = sr_[i].kr; } while (0)
#define LSYNC() do { if (!(ABL & 2)) __syncthreads(); } while (0)
#define SWAIT() do { if (ABL & 2) break; if (SDEPTH == 2) asm volatile("s_waitcnt vmcnt(3)" ::: "memory"); else asm volatile("s_waitcnt vmcnt(0)" ::: "memory"); } while (0)
#define RESC(a) do { if (__any((a) < 1.f)) { if (hi == 0) al_l[r32] = (a); asm volatile("s_waitcnt lgkmcnt(0)" ::: "memory"); \
    for (int d = 0; d < 4; ++d) for (int r = 0; r < 16; ++r) o[d][r] *= al_l[crow(r, hi)]; } } while (0)
  bool nowrite = false;
  f32x16 pA0, pA1, pB0, pB1; float mnA, mnB, alA, alB; bf16x8 pa0, pa1, pa2, pa3; const int NT = nkeys / 64;
  constexpr int SE = 0, SO = SDEPTH - 1;
  __syncthreads();
  SLOAD(SE, 0); asm volatile("s_waitcnt vmcnt(0)" ::: "memory"); SWRITE(0, SE); __syncthreads();
  qkt<ABL>(pA0, pA1, K_lds, qr, r32, hi); partialSM<ABL>(pA0, pA1, m_reg, mnA, alA);
  SLOAD(SO, 64); if (SDEPTH == 2 && 2 < NT) SLOAD(SE, 2 * 64);
  if (2 < NT) SWAIT(); else asm volatile("s_waitcnt vmcnt(0)" ::: "memory");
  SWRITE(1, SO); __syncthreads();
  nowrite = true;
  int ib_qk = 1, ib_pv = 0, ib_wr = (NBUF == 3) ? 2 : 0;
#define ROT() do { ib_pv = ib_qk; ib_qk = ib_wr; ib_wr = (NBUF == 3) ? (ib_wr == 2 ? 0 : ib_wr + 1) : (ib_wr ^ 1); } while (0)
#define PRE_WRITE_SYNC() do { if (NBUF == 2) LSYNC(); } while (0)
  for (int j = 1; j + 1 < NT; j += 2) {
    SBAR(); qkt<ABL>(pB0, pB1, K_lds + ib_qk * SHM_K, qr, r32, hi);
    finishSM<ABL>(pA0, pA1, alA, l_reg, pa0, pa1, pa2, pa3); SBAR();
    SLOAD(SO, (j + SDEPTH) * 64); SBAR();
    pv_d0<ABL>(o, vb0 + ib_pv * SHM_V, pa0, pa1, pa2, pa3); partialSM<ABL>(pB0, pB1, m_reg, mnB, alB);
    PRE_WRITE_SYNC(); SWAIT(); SWRITE(ib_wr, SE);
    RESC(alB); LSYNC(); ROT();
    SBAR(); qkt<ABL>(pA0, pA1, K_lds + ib_qk * SHM_K, qr, r32, hi);
    finishSM<ABL>(pB0, pB1, alB, l_reg, pa0, pa1, pa2, pa3); SBAR();
    if (SDEPTH == 1 || j + 3 < NT) SLOAD(SE, (j + 1 + SDEPTH) * 64); SBAR();
    pv_d0<ABL>(o, vb0 + ib_pv * SHM_V, pa0, pa1, pa2, pa3); partialSM<ABL>(pA0, pA1, m_reg, mnA, alA);
    PRE_WRITE_SYNC(); if (SDEPTH == 2 && j + 3 < NT) SWAIT(); else asm volatile("s_waitcnt vmcnt(0)" ::: "memory");
    SWRITE(ib_wr, SO);
    RESC(alA); LSYNC(); ROT();
  }
  SBAR(); qkt<ABL>(pB0, pB1, K_lds + ib_qk * SHM_K, qr, r32, hi);
  finishSM<ABL>(pA0, pA1, alA, l_reg, pa0, pa1, pa2, pa3); SBAR();
  pv_d0<ABL>(o, vb0 + ib_pv * SHM_V, pa0, pa1, pa2, pa3); partialSM<ABL>(pB0, pB1, m_reg, mnB, alB);
  __syncthreads(); RESC(alB);
  finishSM<ABL>(pB0, pB1, alB, l_reg, pa0, pa1, pa2, pa3); SBAR();
  pv_d0<ABL>(o, vb0 + ib_qk * SHM_V, pa0, pa1, pa2, pa3);
#undef ROT
#undef PRE_WRITE_SYNC
  if (hi == 0) li_l[r32] = l_reg; asm volatile("s_waitcnt lgkmcnt(0)" ::: "memory");
  bf16_t* Ow = Og + (size_t)(qrow0 + wid * 32) * DM + h * 128;
  const bool odd = lane & 1;
#pragma unroll
  for (int r = 0; r < 16; r += 2) { const float ra = __builtin_amdgcn_rcpf(li_l[crow(r, hi)]), rb = __builtin_amdgcn_rcpf(li_l[crow(r + 1, hi)]);
#pragma unroll
    for (int d0 = 0; d0 < 4; ++d0) { const float a = o[d0][r] * ra, b = o[d0][r + 1] * rb;
      const float recv = __shfl_xor(odd ? a : b, 1);
      const unsigned w = odd ? cvt_pk_bf16(recv, b) : cvt_pk_bf16(a, recv);
      const int orow = crow(odd ? r + 1 : r, hi);
      *(unsigned*)(Ow + (size_t)orow * DM + d0 * 32 + (r32 & ~1)) = w; } }
#undef SLOAD
#undef SWRITE
#undef SWAIT
#undef LSYNC
#undef RESC
}
#undef SBAR
}


namespace attn2 {
using namespace attn;
#define SBAR() __builtin_amdgcn_sched_barrier(0)
template <bool GX, int AB2 = 0>
__device__ __forceinline__ void unit(char* lds, const bf16_t* __restrict__ Qg, const bf16_t* __restrict__ Kb, bf16_t* __restrict__ Og, const float* rstdq, const f32x2* tab,
                                     int qrow0, int h, int nkeys) {
  int tid_l = threadIdx.x; asm volatile("" : "+v"(tid_l));
  const int tid = tid_l, wid = tid >> 6, lane = tid & 63, r32 = lane & 31, hi = lane >> 5;
  const int lw = ATTN2_GSEL == 0 ? (wid & 3) : ATTN2_GSEL == 1 ? (wid >> 1) : ((wid & 1) | ((wid >> 2) << 1)), gt = lw * 64 + lane;
  constexpr int SHK = ATTN2_DMA ? SHM_K2 : SHM_K;
  char* V_lds = lds; char* K_lds = lds + 2 * SHM_V;
  float* ws = (float*)(lds + 2 * SHM_V + 2 * SHK) + wid * 64; float* li_l = ws; float* al_l = ws + 32;
  float m_reg = -1e30f, l_reg = 0; f32x16 o[4] = {}; bf16x8 qr[12];
  { const int row = qrow0 + wid * 32 + r32; const float rs = rstdq[row]; const bf16_t* Qw = Qg + (size_t)row * QW + h * 192 + hi * 8;
#pragma unroll
    for (int d0 = 0; d0 < 12; ++d0) { const u32x4 q = *(const u32x4*)(Qw + d0 * 16);
      float v[8] = {bflo(q.x), bfhi(q.x), bflo(q.y), bfhi(q.y), bflo(q.z), bfhi(q.z), bflo(q.w), bfhi(q.w)};
      q_fixup(v, row, d0 * 16 + hi * 8, rs, tab);
      u32x4 w = {cvt_pk_bf16(v[0], v[1]), cvt_pk_bf16(v[2], v[3]), cvt_pk_bf16(v[4], v[5]), cvt_pk_bf16(v[6], v[7])}; qr[d0] = *reinterpret_cast<bf16x8*>(&w); } }
  const int vb0 = (int)(uintptr_t)V_lds + v_rd_base(lane);
#if ATTN2_DMA
  const int lwu = __builtin_amdgcn_readfirstlane(lw);
  unsigned koff[GX ? 6 : 1];
  if (GX) {
#pragma unroll
    for (int j = 0; j < 6; ++j) { const int q = 64 * (j % 3) + lane, rr = q / 24, cc = q - 24 * rr, r = 8 * (2 * lw + j / 3) + rr; koff[j] = (unsigned)(r * 384 + ((cc ^ ((r >> 1) & 7)) << 4)); }
  } else koff[0] = (unsigned)((((gt >> 7) * 8 + ((gt >> 2) & 7)) * 384) + ((gt >> 5) & 3) * 64 + (gt & 3) * 16);
  const int sw_ = (r32 >> 1) & 7, kb0 = (int)(uintptr_t)K_lds + r32 * KROW2 + ((hi ^ (sw_ & 1)) << 4), kt = sw_ >> 1;
#define DMA_K(t) do { const char* src_ = (const char*)Kb + (size_t)(t) * (64 * KW * 2); char* dst_ = K_lds + ((t) & 1) * SHM_K2 + lwu * 6144; \
    _Pragma("unroll") for (int j = 0; j < 6; ++j) __builtin_amdgcn_global_load_lds((const unsigned*)(src_ + koff[j]), (__attribute__((address_space(3))) unsigned*)(dst_ + j * 1024), 16, 0, 0); } while (0)
#define DMA_V(t) do { const char* src_ = (const char*)Kb + (size_t)(t) * (64 * KW * 2) + koff[0]; char* dst_ = V_lds + ((t) & 1) * SHM_V + lwu * 1024; \
    _Pragma("unroll") for (int i = 0; i < 4; ++i) __builtin_amdgcn_global_load_lds((const unsigned*)(src_ + i * (16 * KW * 2)), (__attribute__((address_space(3))) unsigned*)(dst_ + i * 4096), 16, 0, 0); } while (0)
#define VM0() asm volatile("s_waitcnt vmcnt(0)" ::: "memory")
#define QKT(k) qkt_asm2(p0, p1, kb0 + ((k) & 1) * SHM_K2, kt, qr)
#else
#define QKT(k) qkt_asm(p0, p1, K_lds + ((k) & 1) * SHM_K, qr, r32, hi)
#endif
  constexpr int NCH = ATTN2_DMA ? 1 : (GX ? 6 : 4);
  bf16x8 stg[NCH];
#define STAGE_LOAD(t) do { _Pragma("unroll") for (int i = 0; i < NCH; ++i) { const int id = gt + 256 * i; \
    stg[i] = GX ? *(const bf16x8*)(Kb + (size_t)(t) * 64 * KW + id * 8) : *(const bf16x8*)(Kb + (size_t)((t) * 64 + (id >> 4)) * KW + (id & 15) * 8); } } while (0)
#define STAGE_WRITE(t) do { _Pragma("unroll") for (int i = 0; i < NCH; ++i) { const int id = gt + 256 * i; \
    if (GX) { const int key = (id * 2731) >> 16; *(bf16x8*)(K_lds + ((t) & 1) * SHM_K + id * 16 + key * 16) = stg[i]; } \
    else *(bf16x8*)(V_lds + ((t) & 1) * SHM_V + v_st(id >> 4, (id & 15) * 8)) = stg[i]; } } while (0)
#define RESC(a) do { if (__any((a) < 1.f)) { if (hi == 0) al_l[r32] = (a); asm volatile("s_waitcnt lgkmcnt(0)" ::: "memory"); \
    for (int d = 0; d < 4; ++d) for (int r = 0; r < 16; ++r) o[d][r] *= al_l[crow(r, hi)]; } } while (0)
  f32x16 p0 = {}, p1 = {}; float mn = 0.f, al = 1.f; bf16x8 pa0 = {}, pa1 = {}, pa2 = {}, pa3 = {}; const int NT = nkeys / 64;
  __syncthreads();
#if ATTN2_DMA
  if (GX) { DMA_K(0); VM0(); }
#else
  if (GX) { STAGE_LOAD(0); STAGE_WRITE(0); }
#endif
  __syncthreads();
#if ATTN2_DMA && ATTN2_MSEG
#define MSEG(PVF, QKF, k) m_seg<PVF, QKF>(p0, p1, o, pa0, pa1, pa2, pa3, kb0 + ((k) & 1) * SHM_K2, kt, vb0 + (((k) - 1) & 1) * SHM_V, qr, negm)
#if SM_NEGM
  f32x16 negm = {}; bool first = true; m_reg = 0.f;
#define SOFTMAX() do { partialSM_negm(p0, p1, m_reg, al, negm, first); first = false; RESC(al); finishSM<0>(p0, p1, al, l_reg, pa0, pa1, pa2, pa3); } while (0)
#else
  const f32x16 negm = {};
#define SOFTMAX() do { partialSM<0>(p0, p1, m_reg, mn, al); RESC(al); finishSM<0>(p0, p1, al, l_reg, pa0, pa1, pa2, pa3); } while (0)
#endif
  if (GX) {
    if (1 < NT) DMA_K(1); SBAR(); MSEG(false, true, 0); __syncthreads();
    SBAR(); SOFTMAX(); SBAR(); VM0(); __syncthreads();
    for (int k = 1; k < NT; ++k) {
      if (k + 1 < NT) DMA_K(k + 1); SBAR(); MSEG(true, true, k); __syncthreads();
      SBAR(); SOFTMAX(); SBAR(); VM0(); __syncthreads();
    }
    MSEG(true, false, NT); __syncthreads(); __syncthreads();
  } else {
    DMA_V(0); __syncthreads();
    SBAR(); MSEG(false, true, 0); VM0(); __syncthreads();
    for (int k = 1; k < NT; ++k) {
      DMA_V(k); SBAR(); SOFTMAX(); SBAR(); __syncthreads();
      SBAR(); MSEG(true, true, k); VM0(); __syncthreads();
    }
    SBAR(); SOFTMAX(); SBAR(); __syncthreads();
    MSEG(true, false, NT); __syncthreads();
  }
#undef MSEG
#undef SOFTMAX
#else
  for (int k = 0; k <= NT; ++k) {
    if (GX) {
      __builtin_amdgcn_s_setprio(ATTN2_PM); SBAR();
#if ATTN2_DMA
      if (k + 1 < NT) DMA_K(k + 1);
      SBAR();
#endif
#if ATTN2_DMA && ATTN2_MSEG
      { const int kbk = kb0 + (k & 1) * SHM_K2, vbk = vb0 + ((k - 1) & 1) * SHM_V;
        if (k >= 1 && k < NT) m_seg<true, true>(p0, p1, o, pa0, pa1, pa2, pa3, kbk, kt, vbk, qr); else if (k < NT) m_seg<false, true>(p0, p1, o, pa0, pa1, pa2, pa3, kbk, kt, vbk, qr); else m_seg<true, false>(p0, p1, o, pa0, pa1, pa2, pa3, kbk, kt, vbk, qr); }
#else
      if (k >= 1) { if (!(AB2 & 2)) pv_d0<0>(o, vb0 + ((k - 1) & 1) * SHM_V, pa0, pa1, pa2, pa3); else { asm volatile("" :: "v"(pa0), "v"(pa1), "v"(pa2), "v"(pa3)); asm volatile("" : "+v"(o[0]), "+v"(o[1]), "+v"(o[2]), "+v"(o[3])); } }
      if (k < NT) { if (!(AB2 & 2)) QKT(k); else asm volatile("" : "+v"(p0), "+v"(p1)); }
#endif
      __syncthreads();
      __builtin_amdgcn_s_setprio(ATTN2_PV); SBAR();
#if !ATTN2_DMA
      if (k + 1 < NT) STAGE_LOAD(k + 1);
#endif
      SBAR();
      if (k < NT) { if (!(AB2 & 1)) { partialSM<0>(p0, p1, m_reg, mn, al); RESC(al); finishSM<0>(p0, p1, al, l_reg, pa0, pa1, pa2, pa3); } else { asm volatile("" :: "v"(p0), "v"(p1)); asm volatile("" : "+v"(pa0), "+v"(pa1), "+v"(pa2), "+v"(pa3)); } }
      SBAR();
#if ATTN2_DMA
      VM0();
#else
      if (k + 1 < NT) STAGE_WRITE(k + 1);
#endif
      __syncthreads();
    } else {
      __builtin_amdgcn_s_setprio(ATTN2_PV); SBAR();
#if ATTN2_DMA
      if (k < NT) DMA_V(k);
#else
      if (k < NT) STAGE_LOAD(k);
#endif
      SBAR();
      if (k >= 1) { if (!(AB2 & 1)) { partialSM<0>(p0, p1, m_reg, mn, al); RESC(al); finishSM<0>(p0, p1, al, l_reg, pa0, pa1, pa2, pa3); } else { asm volatile("" :: "v"(p0), "v"(p1)); asm volatile("" : "+v"(pa0), "+v"(pa1), "+v"(pa2), "+v"(pa3)); } }
      SBAR();
#if !ATTN2_DMA
      if (k < NT) STAGE_WRITE(k);
#endif
      __syncthreads();
      __builtin_amdgcn_s_setprio(ATTN2_PM); SBAR();
#if ATTN2_DMA && ATTN2_MSEG
      { const int kbk = kb0 + (k & 1) * SHM_K2, vbk = vb0 + ((k - 1) & 1) * SHM_V;
        if (k >= 1 && k < NT) m_seg<true, true>(p0, p1, o, pa0, pa1, pa2, pa3, kbk, kt, vbk, qr); else if (k < NT) m_seg<false, true>(p0, p1, o, pa0, pa1, pa2, pa3, kbk, kt, vbk, qr); else m_seg<true, false>(p0, p1, o, pa0, pa1, pa2, pa3, kbk, kt, vbk, qr); }
#else
      if (k >= 1) { if (!(AB2 & 2)) pv_d0<0>(o, vb0 + ((k - 1) & 1) * SHM_V, pa0, pa1, pa2, pa3); else { asm volatile("" :: "v"(pa0), "v"(pa1), "v"(pa2), "v"(pa3)); asm volatile("" : "+v"(o[0]), "+v"(o[1]), "+v"(o[2]), "+v"(o[3])); } }
      if (k < NT) { if (!(AB2 & 2)) QKT(k); else asm volatile("" : "+v"(p0), "+v"(p1)); }
#endif
#if ATTN2_DMA
      VM0();
#endif
      __syncthreads();
    }
  }
#endif
  __builtin_amdgcn_s_setprio(0);
  if (hi == 0) li_l[r32] = l_reg; asm volatile("s_waitcnt lgkmcnt(0)" ::: "memory");
  bf16_t* Ow = Og + (size_t)(qrow0 + wid * 32) * DM + h * 128;
  const bool odd = lane & 1;
#pragma unroll
  for (int r = 0; r < 16; r += 2) { const float ra = __builtin_amdgcn_rcpf(li_l[crow(r, hi)]), rb = __builtin_amdgcn_rcpf(li_l[crow(r + 1, hi)]);
#pragma unroll
    for (int d0 = 0; d0 < 4; ++d0) { const float a = o[d0][r] * ra, b = o[d0][r + 1] * rb;
      const float recv = __shfl_xor(odd ? a : b, 1);
      const unsigned w = odd ? cvt_pk_bf16(recv, b) : cvt_pk_bf16(a, recv);
      const int orow = crow(odd ? r + 1 : r, hi);
      *(unsigned*)(Ow + (size_t)orow * DM + d0 * 32 + (r32 & ~1)) = w; } }
#undef STAGE_LOAD
#undef STAGE_WRITE
#undef RESC
#undef QKT
#if ATTN2_DMA
#undef DMA_K
#undef DMA_V
#undef VM0
#endif
}
#undef SBAR
}

template <class Src>
__device__ __forceinline__ void transpose_item(bf16_t* WT, int K, int item, int nblk, float* scr, int lane, const Src& src, const bool NTS = false) {
    const int kb = item / nblk, nb = item % nblk, k0 = 64 * kb, n0 = 32 * nb;
    float tv[32];
#pragma unroll
    for (int i = 0; i < 32; ++i) tv[i] = src(k0 + 2 * i + (lane >> 5), n0 + (lane & 31));
#pragma unroll
    for (int i = 0; i < 32; ++i) { const int kk = 2 * i + (lane >> 5); scr[kk * 33 + (lane & 31)] = tv[i]; }
    asm volatile("s_waitcnt lgkmcnt(0)" ::: "memory");
    const int c = lane & 7;
#pragma unroll
    for (int j = 0; j < 4; ++j) { const int n = (lane >> 3) + 8 * j; const float* s = scr + (8 * c) * 33 + n;
        u32x4 o; o.x = cvt_pk_bf16(s[0 * 33], s[1 * 33]); o.y = cvt_pk_bf16(s[2 * 33], s[3 * 33]); o.z = cvt_pk_bf16(s[4 * 33], s[5 * 33]); o.w = cvt_pk_bf16(s[6 * 33], s[7 * 33]);
        if (NTS) __builtin_nontemporal_store(o, (u32x4*)(WT + (size_t)(n0 + n) * K + k0 + 8 * c)); else *(u32x4*)(WT + (size_t)(n0 + n) * K + k0 + 8 * c) = o; }
    asm volatile("s_waitcnt lgkmcnt(0)" ::: "memory");
}
template <bool R_DFAST = false, class PF, class RF>
__device__ __forceinline__ void fold_tile(bf16_t* out, int Kout, unsigned char* lds, const PF& P, const RF& R) {
    float* Ps = (float*)lds;
    float* Rt = Ps + 64 * 132;
    bf16_t* Os = (bf16_t*)(Rt + 64 * 132);
    const int t = threadIdx.x;
    __syncthreads();
    { float pv[16], rv[16];
#pragma unroll
      for (int j = 0; j < 16; ++j) { const int i = t + j * NTHREADS; pv[j] = P(i >> 7, i & 127); }
#pragma unroll
      for (int j = 0; j < 16; ++j) { const int i = t + j * NTHREADS; rv[j] = R(R_DFAST ? (i & 127) : (i >> 6), R_DFAST ? (i >> 7) : (i & 63)); }
#pragma unroll
      for (int j = 0; j < 16; ++j) { const int i = t + j * NTHREADS; Ps[(i >> 7) * 132 + (i & 127)] = pv[j]; }
#pragma unroll
      for (int j = 0; j < 16; ++j) { const int i = t + j * NTHREADS; const int d = R_DFAST ? (i & 127) : (i >> 6), nn = R_DFAST ? (i >> 7) : (i & 63); Rt[nn * 132 + d] = rv[j]; } }
    __syncthreads();
#if FOLD_MFMA
    { const int wv = t >> 6, ln = t & 63, i32 = ln & 31, kbit = ln >> 5, ib = wv & 1, jb = (wv >> 1) & 1, dh = wv >> 2;
      float* red = (float*)(Os + 64 * 72);
      f32x16 acc = {};
      const float* ra = Rt + (ib * 32 + i32) * 132 + dh * 64 + 4 * kbit; const float* pb = Ps + (jb * 32 + i32) * 132 + dh * 64 + 4 * kbit;
#pragma unroll
      for (int m = 0; m < 8; ++m) { const f32x4 av = *(const f32x4*)(ra + 8 * m), bv = *(const f32x4*)(pb + 8 * m);
          acc = __builtin_amdgcn_mfma_f32_32x32x2f32(av.x, bv.x, acc, 0, 0, 0); acc = __builtin_amdgcn_mfma_f32_32x32x2f32(av.y, bv.y, acc, 0, 0, 0);
          acc = __builtin_amdgcn_mfma_f32_32x32x2f32(av.z, bv.z, acc, 0, 0, 0); acc = __builtin_amdgcn_mfma_f32_32x32x2f32(av.w, bv.w, acc, 0, 0, 0); }
      if (dh == 1) {
#pragma unroll
          for (int r = 0; r < 16; ++r) red[((wv & 3) * 16 + r) * 64 + ln] = acc[r]; }
      __syncthreads();
      if (dh == 0) {
#pragma unroll
          for (int r = 0; r < 16; ++r) { const float v = acc[r] + red[((wv & 3) * 16 + r) * 64 + ln]; const int nn_ = ib * 32 + (r & 3) + 8 * (r >> 2) + 4 * kbit;
              Os[nn_ * 72 + jb * 32 + i32] = (bf16_t)(cvt_pk_bf16(v, 0.f) & 0xffffu); } }
    }
    __syncthreads();
    { const int nn = t >> 3, kq = t & 7; *(u32x4*)(out + (size_t)nn * Kout + kq * 8) = *(const u32x4*)(Os + nn * 72 + kq * 8); }
#else
    const int nn = t >> 3, kq = t & 7;
    float a[8];
#pragma unroll
    for (int i = 0; i < 8; ++i) a[i] = 0.f;
    for (int d4 = 0; d4 < 32; ++d4) { const f32x4 r = *(const f32x4*)(Rt + nn * 132 + d4 * 4);
#pragma unroll
        for (int i = 0; i < 8; ++i) { const f32x4 p = *(const f32x4*)(Ps + (kq + 8 * i) * 132 + d4 * 4); a[i] += p.x * r.x + p.y * r.y + p.z * r.z + p.w * r.w; } }
#pragma unroll
    for (int i = 0; i < 8; ++i) Os[nn * 72 + kq + 8 * i] = (bf16_t)(cvt_pk_bf16(a[i], 0.f) & 0xffffu);
    __syncthreads();
    *(u32x4*)(out + (size_t)nn * Kout + kq * 8) = *(const u32x4*)(Os + nn * 72 + kq * 8);
#endif
}

__device__ __forceinline__ void p0_transposes(const Ctx& C, unsigned char* lds, const int l, const int worker, const int nw, const int r_lo = 0, const int r_hi = 1 << 30) {
    {
        float* scr = (float*)(lds + C.wave * 16384);
        const int gw = worker * NWAVES + C.wave, NGW = nw * NWAVES;
        constexpr int I_IN = (DM / 64) * (NIN / 32), I_QR = (QL / 64) * (NH * 64 / 32), I_OUT = (DM / 64) * (DM / 32), I_GU = (DM / 64) * (NGU / 32), I_DN = (DFF / 64) * (DM / 32);
        constexpr int PER_LAYER = I_IN + I_QR + I_OUT + I_GU + I_DN;
        for (int it = r_lo + gw; it < (r_hi < PER_LAYER ? r_hi : PER_LAYER); it += NGW) {
            int r = it;
            bf16_t* W = (bf16_t*)(C.ws + WS_W + (size_t)l * LW_BYTES);
            if (r < I_IN) { const float* w = C.in(7) + (size_t)l * DM * DIN;
                transpose_item(W + W_IN, DM, r, NIN / 32, scr, C.lane, [=](int k, int n) { const float v = __builtin_nontemporal_load(w + (size_t)k * DIN + (n < DIN ? n : DIN - 1)); return n < DIN ? v : 0.f; }, l > 0); continue; } r -= I_IN;
            if (r < I_QR) { const float* w = C.in(9) + (size_t)l * QL * QW; const float* gq = C.in(8) + l * QL;
                const int nblk = NH * 64 / 32, kb = r / nblk, nb = r % nblk, hh = nb >> 1, e0 = (nb & 1) * 32;
                bf16_t* dst = W + W_Q + (size_t)(hh * 192 + 128 + e0 - 32 * nb) * QL;
                transpose_item(dst, QL, kb * nblk + nb, nblk, scr, C.lane, [=](int k, int n) { const int e = n & 63, hd = n >> 6, p = e >> 1, comp = e & 1;
                    return w[(size_t)k * QW + hd * 192 + 128 + (p >> 4) * 32 + comp * 16 + (p & 15)] * gq[k] * C2; }, l > 0); continue; } r -= I_QR;
            if (r < I_OUT) { const float* w = C.in(16) + (size_t)l * DM * DM;
                transpose_item(W + W_OUT, DM, r, DM / 32, scr, C.lane, [=](int k, int n) { return __builtin_nontemporal_load(w + (size_t)k * DM + n); }, l > 0); continue; } r -= I_OUT;
            if (r < I_GU) { const float* wg = C.in(19) + (size_t)l * DM * DFF; const float* wu = C.in(20) + (size_t)l * DM * DFF;
                transpose_item(W + W_GU, DM, r, NGU / 32, scr, C.lane, [=](int k, int n) { const int tile = n >> 8, hf = (n >> 7) & 1, cc = n & 127; return __builtin_nontemporal_load((hf ? wu : wg) + (size_t)k * DFF + tile * 128 + cc); }, l > 0); continue; } r -= I_GU;
            { const float* w = C.in(21) + (size_t)l * DFF * DM;
                transpose_item(W + W_DN, DFF, r, DM / 32, scr, C.lane, [=](int k, int n) { return __builtin_nontemporal_load(w + (size_t)k * DM + n); }, l > 0); }
        }
    }
}
__device__ __forceinline__ void p0_folds(const Ctx& C, unsigned char* lds, const int l, const int worker, const int nw) {
    {
        constexpr int T_Q = NH * 2 * 4, T_O = 16 * 16, T_PC = 16 * 8, PER_LAYER = T_Q + T_O + T_PC;
        for (int it = worker; it < PER_LAYER; it += nw) {
            int r = it;
            bf16_t* W = (bf16_t*)(C.ws + WS_W + (size_t)l * LW_BYTES);
            const float* w_uq = C.in(9) + (size_t)l * QL * QW; const float* w_ukv = C.in(11) + (size_t)l * KVL * 2048; const float* gq = C.in(8) + l * QL;
            if (r < T_Q) { const int hh = r >> 3, jt = (r >> 2) & 1, itile = r & 3;
                fold_tile<true>(W + W_Q + (size_t)(hh * 192 + jt * 64) * QL + itile * 64, QL, lds,
                          [=](int kk, int d) { const int i = itile * 64 + kk; return w_uq[(size_t)i * QW + hh * 192 + d] * gq[i] * C2; },
                          [=](int d, int nn) { return w_ukv[(size_t)(jt * 64 + nn) * 2048 + hh * 256 + d]; });
                continue; } r -= T_Q;
            if (r < T_O) { const int nt = r >> 4, kt = r & 15, hh = kt >> 1, j0 = (kt & 1) * 64; const float* w_o = C.in(12) + (size_t)l * DM * DM;
                fold_tile(W + W_O + (size_t)(nt * 64) * DM + hh * 128 + j0, DM, lds,
                          [=](int kk, int d) { return w_ukv[(size_t)(j0 + kk) * 2048 + hh * 256 + 128 + d]; },
                          [=](int d, int nn) { return w_o[(size_t)(hh * 128 + d) * DM + nt * 64 + nn]; });
                continue; } r -= T_O;
            { const int nt = r >> 3, kt = r & 7, gg = kt >> 1, c0 = (kt & 1) * 64; const float* w_pool = C.in(13) + ((size_t)l * 4 + gg) * 128 * 128; const float* psc = C.in(14) + l * PW + gg * 128;
              const float* w_op = C.in(15) + (size_t)l * PW * DM;
                fold_tile(W + W_PC + (size_t)(nt * 64) * PW + gg * 128 + c0, PW, lds,
                          [=](int kk, int d) { return w_pool[(size_t)(c0 + kk) * 128 + d] * psc[d]; },
                          [=](int d, int nn) { return w_op[(size_t)(gg * 128 + d) * DM + nt * 64 + nn]; }); }
        }
    }
    __syncthreads();
}
__device__ __forceinline__ void p0_mod_tab(const Ctx& C, unsigned char* lds) {
    const float* w_ada = C.in(4); const float* b_ada = C.in(5);
    {
        float* sv = (float*)lds;
        float* red = sv + 5 * DM;
        float* MOD = (float*)(C.ws + WS_MOD);
        const int t = C.tid, ks = t >> 6, cc = t & 63;
        bool have = false;
        for (int it = C.bid; it < DEPTH * (NMOD * DM / 64); it += C.G) {
            const int l = it / (NMOD * DM / 64), n0 = (it % (NMOD * DM / 64)) * 64;
            __syncthreads();
            if (!have) { for (int i = t; i < 5 * DM; i += NTHREADS) { const int s = i / DM, k = i % DM; const float* src = s < 4 ? C.in(1) + s * DM : C.in(3); const float v = src[k]; sv[i] = v / (1.f + __expf(-v)); } have = true; __syncthreads(); }
#if MOD_WIDE
            { const int cq = t & 15, kg = t >> 4; f32x4 acc[5];
#pragma unroll
              for (int s_ = 0; s_ < 5; ++s_) acc[s_] = (f32x4){0.f, 0.f, 0.f, 0.f};
              const float* Wq = w_ada + (size_t)l * DM * (NMOD * DM) + n0 + 4 * cq;
#pragma unroll
              for (int hb = 0; hb < 2; ++hb) { f32x4 w[16];
#pragma unroll
                for (int i = 0; i < 16; ++i) w[i] = __builtin_nontemporal_load((const f32x4*)(Wq + (size_t)(kg * 32 + hb * 16 + i) * (NMOD * DM)));
#pragma unroll
                for (int i = 0; i < 16; ++i) { const int k = kg * 32 + hb * 16 + i;
#pragma unroll
                  for (int s_ = 0; s_ < 5; ++s_) acc[s_] += w[i] * sv[s_ * DM + k]; } }
#pragma unroll
              for (int s_ = 0; s_ < 5; ++s_) *(f32x4*)(red + (kg * 5 + s_) * 64 + 4 * cq) = acc[s_]; }
            __syncthreads();
            if (t < 320) { const int s = t >> 6; float v = b_ada[l * NMOD * DM + n0 + cc];
#pragma unroll
                for (int q = 0; q < 32; ++q) v += red[(q * 5 + s) * 64 + cc];
                MOD[((size_t)l * 5 + s) * NMOD * DM + n0 + cc] = v; }
#else
            float a0 = 0, a1 = 0, a2 = 0, a3 = 0, a4 = 0;
            const float* Wp = w_ada + (size_t)l * DM * (NMOD * DM) + n0 + cc;
#pragma unroll 32
            for (int k = ks * 128; k < ks * 128 + 128; ++k) { const float w = __builtin_nontemporal_load(Wp + (size_t)k * (NMOD * DM)); a0 += sv[k] * w; a1 += sv[DM + k] * w; a2 += sv[2 * DM + k] * w; a3 += sv[3 * DM + k] * w; a4 += sv[4 * DM + k] * w; }
            red[(ks * 5 + 0) * 64 + cc] = a0; red[(ks * 5 + 1) * 64 + cc] = a1; red[(ks * 5 + 2) * 64 + cc] = a2; red[(ks * 5 + 3) * 64 + cc] = a3; red[(ks * 5 + 4) * 64 + cc] = a4;
            __syncthreads();
            if (t < 320) { const int s = t >> 6; float v = b_ada[l * NMOD * DM + n0 + cc];
#pragma unroll
                for (int q = 0; q < 8; ++q) v += red[(q * 5 + s) * 64 + cc];
                MOD[((size_t)l * 5 + s) * NMOD * DM + n0 + cc] = v; }
#endif
        }
        __syncthreads();
    }
    if (C.bid == C.G - 1) {
        f32x2* tab = (f32x2*)(C.ws + WS_TAB);
        for (int i = C.tid; i < 64 * 16; i += NTHREADS) { const int pos = i >> 4, f = i & 15; const float inv = powf(10000.f, -(float)(2 * f) / 32.f), ang = (float)pos * inv;
            tab[i] = (f32x2){cosf(ang), sinf(ang)}; }
    }
}

__device__ __forceinline__ void row_pass(const Ctx& C, int row_lo, int row_hi, bool from_input, const bf16_t* Yb, const float* gpost, int kg,
                                         bf16_t* hdst, const float* gpre, const float* mod_res, const float* mod_h, int ksc, int ksh, const bf16_t* slab = nullptr) {
    const int gw = C.bid * NWAVES + C.wave, NGW = C.G * NWAVES, lane = C.lane;
#if ROW_CHUNK
    const int nctx = (row_lo < NCTX) ? ((row_hi < NCTX ? row_hi : NCTX) - row_lo) : 0, lat_lo = row_lo + nctx;
    const int nstr = (gw < nctx) ? (nctx - gw + NGW - 1) / NGW : 0;
    const int per = (row_hi - lat_lo + NGW - 1) / NGW, rbeg = lat_lo + gw * per, rend0 = (rbeg + per < row_hi) ? rbeg + per : row_hi, nrun = rend0 > rbeg ? rend0 - rbeg : 0;
    f32x4 gp[4], mg[4], gq[4], sc[4], sh[4];
    if (Yb) {
#pragma unroll
        for (int j = 0; j < 4; ++j) gp[j] = ((const f32x4*)gpost)[lane + 64 * j]; }
    if (hdst) {
#pragma unroll
        for (int j = 0; j < 4; ++j) gq[j] = ((const f32x4*)gpre)[lane + 64 * j]; }
    int cur_slot = -1;
    for (int it_ = 0; it_ < nstr + nrun; ++it_) {
        const int r = it_ < nstr ? row_lo + gw + it_ * NGW : rbeg + (it_ - nstr);
        const int slot = mod_slot(r);
        f32x4 x[4], y[4];
        if (slot != cur_slot) { cur_slot = slot;
            if (Yb) { const float* mgp = mod_res + (size_t)slot * NMOD * DM + kg * DM;
#pragma unroll
                for (int j = 0; j < 4; ++j) mg[j] = ((const f32x4*)mgp)[lane + 64 * j]; }
            if (hdst) { const float* msc = mod_h + (size_t)slot * NMOD * DM + ksc * DM; const float* msh = mod_h + (size_t)slot * NMOD * DM + ksh * DM;
#pragma unroll
                for (int j = 0; j < 4; ++j) { sc[j] = ((const f32x4*)msc)[lane + 64 * j]; sh[j] = ((const f32x4*)msh)[lane + 64 * j]; } } }
        if (!XS_BF16 || !Yb || from_input) {
            const f32x4* xr = (const f32x4*)((!Yb || from_input) ? xin_row(C, r) : xs_row(C, r)) + lane;
#pragma unroll
            for (int j = 0; j < 4; ++j) x[j] = __builtin_nontemporal_load(xr + 64 * j);
        } else {
            const u32x2* xr = (const u32x2*)xs_row(C, r) + lane;
#pragma unroll
            for (int j = 0; j < 4; ++j) { const u32x2 xx = __builtin_nontemporal_load(xr + 64 * j); x[j] = (f32x4){bflo(xx.x), bfhi(xx.x), bflo(xx.y), bfhi(xx.y)}; }
        }
        if (Yb) {
            const u32x2* yr = (const u32x2*)(Yb + (size_t)r * DM) + lane;
            if (slab && r < NCTX) {
#pragma unroll
                for (int j = 0; j < 4; ++j) { y[j] = (f32x4){0.f, 0.f, 0.f, 0.f};
                    for (int ks = 0; ks < NSD; ++ks) { const u32x2 yy = ((const u32x2*)(slab + ((size_t)ks * NCTX + r) * DM))[lane + 64 * j]; y[j] += (f32x4){bflo(yy.x), bfhi(yy.x), bflo(yy.y), bfhi(yy.y)}; } }
            } else {
#pragma unroll
                for (int j = 0; j < 4; ++j) { const u32x2 yy = __builtin_nontemporal_load(yr + 64 * j); y[j] = (f32x4){bflo(yy.x), bfhi(yy.x), bflo(yy.y), bfhi(yy.y)}; }
            }
        }
#else
    for (int r = row_lo + gw; r < row_hi; r += NGW) {
        const int slot = mod_slot(r);
        f32x4 x[4], y[4], gp[4], mg[4], gq[4], sc[4], sh[4];
        if (!XS_BF16 || !Yb || from_input) {
            const f32x4* xr = (const f32x4*)((!Yb || from_input) ? xin_row(C, r) : xs_row(C, r)) + lane;
#pragma unroll
            for (int j = 0; j < 4; ++j) x[j] = __builtin_nontemporal_load(xr + 64 * j);
        } else {
            const u32x2* xr = (const u32x2*)xs_row(C, r) + lane;
#pragma unroll
            for (int j = 0; j < 4; ++j) { const u32x2 xx = __builtin_nontemporal_load(xr + 64 * j); x[j] = (f32x4){bflo(xx.x), bfhi(xx.x), bflo(xx.y), bfhi(xx.y)}; }
        }
        if (Yb) {
            const u32x2* yr = (const u32x2*)(Yb + (size_t)r * DM) + lane;
            if (slab && r < NCTX) {
#pragma unroll
                for (int j = 0; j < 4; ++j) { y[j] = (f32x4){0.f, 0.f, 0.f, 0.f};
                    for (int ks = 0; ks < NSD; ++ks) { const u32x2 yy = ((const u32x2*)(slab + ((size_t)ks * NCTX + r) * DM))[lane + 64 * j]; y[j] += (f32x4){bflo(yy.x), bfhi(yy.x), bflo(yy.y), bfhi(yy.y)}; } }
            } else {
#pragma unroll
                for (int j = 0; j < 4; ++j) { const u32x2 yy = __builtin_nontemporal_load(yr + 64 * j); y[j] = (f32x4){bflo(yy.x), bfhi(yy.x), bflo(yy.y), bfhi(yy.y)}; }
            }
            const float* mgp = mod_res + (size_t)slot * NMOD * DM + kg * DM;
#pragma unroll
            for (int j = 0; j < 4; ++j) { gp[j] = ((const f32x4*)gpost)[lane + 64 * j]; mg[j] = ((const f32x4*)mgp)[lane + 64 * j]; }
        }
        if (hdst) {
            const float* msc = mod_h + (size_t)slot * NMOD * DM + ksc * DM; const float* msh = mod_h + (size_t)slot * NMOD * DM + ksh * DM;
#pragma unroll
            for (int j = 0; j < 4; ++j) { gq[j] = ((const f32x4*)gpre)[lane + 64 * j]; sc[j] = ((const f32x4*)msc)[lane + 64 * j]; sh[j] = ((const f32x4*)msh)[lane + 64 * j]; }
        }
#endif
        if (Yb) {
            float ss = 0.f;
#pragma unroll
            for (int j = 0; j < 4; ++j) ss += y[j].x * y[j].x + y[j].y * y[j].y + y[j].z * y[j].z + y[j].w * y[j].w;
            const float rstd = rsqrtf(wave_sum(ss) * (1.f / DM) + EPS);
            float* xp = xs_row(C, r);
#pragma unroll
            for (int j = 0; j < 4; ++j) { x[j] = x[j] + mg[j] * (y[j] * rstd * gp[j]);
                if (!XS_BF16 || !hdst) __builtin_nontemporal_store(x[j], (f32x4*)xp + lane + 64 * j);
                else { u32x2 w; w.x = cvt_pk_bf16(x[j].x, x[j].y); w.y = cvt_pk_bf16(x[j].z, x[j].w); __builtin_nontemporal_store(w, (u32x2*)xp + lane + 64 * j); } }
        }
        if (hdst) {
            float ss = 0.f;
#pragma unroll
            for (int j = 0; j < 4; ++j) ss += x[j].x * x[j].x + x[j].y * x[j].y + x[j].z * x[j].z + x[j].w * x[j].w;
            const float rstd = rsqrtf(wave_sum(ss) * (1.f / DM) + EPS);
            u32x2* hp = (u32x2*)(hdst + (size_t)r * DM) + lane;
#pragma unroll
            for (int j = 0; j < 4; ++j) { const f32x4 hv = x[j] * rstd * gq[j] * (sc[j] + 1.f) + sh[j]; u32x2 w; w.x = cvt_pk_bf16(hv.x, hv.y); w.y = cvt_pk_bf16(hv.z, hv.w); hp[64 * j] = w; }
        }
    }
}

template <int HW>
__device__ __forceinline__ void pool_strip(const bf16_t* ZA, bf16_t* D, int r0, int seq_lo, int seq_hi, int c) {
    float ps[33]; ps[0] = 0.f;
    float v8[16];
    unsigned short raw[32];
#pragma unroll
    for (int i = 0; i < 32; ++i) { int r = r0 - 8 + i; r = r < seq_lo ? seq_lo : (r >= seq_hi ? seq_hi - 1 : r); raw[i] = ZA[(size_t)r * ZAW + OFF_POOL + c]; }
#pragma unroll
    for (int i = 0; i < 32; ++i) { const int r = r0 - 8 + i; const float v = (r >= seq_lo && r < seq_hi) ? bf2f(raw[i]) : 0.f; ps[i + 1] = ps[i] + v; if (i >= 8 && i < 24) v8[i - 8] = v; }
#pragma unroll
    for (int j = 0; j < 16; ++j) { const int pos = r0 + j; int lo = pos - HW; if (lo < seq_lo) lo = seq_lo; int hi = pos + HW; if (hi > seq_hi) hi = seq_hi;
        const float mean = (ps[j + 8 + HW] - ps[j + 8 - HW]) * __builtin_amdgcn_rcpf((float)(hi - lo));
        D[(size_t)pos * PW + c] = (bf16_t)(cvt_pk_bf16(mean - v8[j], 0.f) & 0xffffu); }
}
template <int HW>
__device__ __forceinline__ void pool_strip2(const bf16_t* ZA, bf16_t* D, int r0, int seq_lo, int seq_hi, int c) {
    float pa[33], pb[33]; pa[0] = 0.f; pb[0] = 0.f;
    float va[16], vb[16];
    unsigned raw[32];
#pragma unroll
    for (int i = 0; i < 32; ++i) { int r = r0 - 8 + i; r = r < seq_lo ? seq_lo : (r >= seq_hi ? seq_hi - 1 : r); raw[i] = *(const unsigned*)(ZA + (size_t)r * ZAW + OFF_POOL + c); }
#pragma unroll
    for (int i = 0; i < 32; ++i) { const int r = r0 - 8 + i; const bool in = (r >= seq_lo && r < seq_hi); const float a = in ? bflo(raw[i]) : 0.f, b = in ? bfhi(raw[i]) : 0.f;
        pa[i + 1] = pa[i] + a; pb[i + 1] = pb[i] + b; if (i >= 8 && i < 24) { va[i - 8] = a; vb[i - 8] = b; } }
#pragma unroll
    for (int j = 0; j < 16; ++j) { const int pos = r0 + j; int lo = pos - HW; if (lo < seq_lo) lo = seq_lo; int hi = pos + HW; if (hi > seq_hi) hi = seq_hi;
        const float rc = __builtin_amdgcn_rcpf((float)(hi - lo));
        const float ma = (pa[j + 8 + HW] - pa[j + 8 - HW]) * rc, mb = (pb[j + 8 + HW] - pb[j + 8 - HW]) * rc;
        *(unsigned*)(D + (size_t)pos * PW + c) = cvt_pk_bf16(ma - va[j], mb - vb[j]); }
}
__device__ __forceinline__ void p3a_rowops(const Ctx& C, int l) {
    const bf16_t* ZA = (const bf16_t*)(C.ws + AR_ZA); bf16_t* KL = (bf16_t*)(C.ws + AR_KL); bf16_t* D = (bf16_t*)(C.ws + AR_D);
    float* RSTDQ = (float*)(C.ws + WS_RSTDQ); const f32x2* tab = (const f32x2*)(C.ws + WS_TAB); const float* gkv = C.in(10) + l * KVL;
    const int gw = C.bid * NWAVES + C.wave, NGW = C.G * NWAVES, lane = C.lane, sub = lane >> 4, l16 = lane & 15;
    const float* SLZ = (const float*)(C.ws + WS_SLZ);
    for (int rb = gw * 4; rb < MROWS; rb += NGW * 4) {
        const int r = rb + sub;
        float kv[8], x1a, x1b, x2a, x2b;
        const int p = 2 * l16, axis = p >> 4, f = p & 15;
        if (l > 0 && r < NCTX) {
#pragma unroll
            for (int i = 0; i < 8; ++i) kv[i] = 0.f;
            x1a = x1b = x2a = x2b = 0.f;
#pragma unroll
            for (int ks = 0; ks < 4; ++ks) { const float* sl = SLZ + ((size_t)ks * NCTX + r) * 256; const f32x4 a0 = ((const f32x4*)sl)[2 * l16], a1 = ((const f32x4*)sl)[2 * l16 + 1];
                kv[0] += a0.x; kv[1] += a0.y; kv[2] += a0.z; kv[3] += a0.w; kv[4] += a1.x; kv[5] += a1.y; kv[6] += a1.z; kv[7] += a1.w;
                const f32x2 u1 = *(const f32x2*)(sl + 128 + axis * 32 + f), u2 = *(const f32x2*)(sl + 128 + axis * 32 + 16 + f); x1a += u1.x; x1b += u1.y; x2a += u2.x; x2b += u2.y; }
        } else {
            const bf16_t* z = ZA + (size_t)r * ZAW;
            const u32x4 q0 = ((const u32x4*)z)[2 * l16], q1 = ((const u32x4*)z)[2 * l16 + 1];
            float ss = 0.f;
            { float t; t = bflo(q0.x); ss += t * t; t = bfhi(q0.x); ss += t * t; t = bflo(q0.y); ss += t * t; t = bfhi(q0.y); ss += t * t; t = bflo(q0.z); ss += t * t; t = bfhi(q0.z); ss += t * t; t = bflo(q0.w); ss += t * t; t = bfhi(q0.w); ss += t * t;
              t = bflo(q1.x); ss += t * t; t = bfhi(q1.x); ss += t * t; t = bflo(q1.y); ss += t * t; t = bfhi(q1.y); ss += t * t; t = bflo(q1.z); ss += t * t; t = bfhi(q1.z); ss += t * t; t = bflo(q1.w); ss += t * t; t = bfhi(q1.w); ss += t * t; }
            ss += __shfl_xor(ss, 1); ss += __shfl_xor(ss, 2); ss += __shfl_xor(ss, 4); ss += __shfl_xor(ss, 8);
            if (l16 == 0) RSTDQ[r] = rsqrtf(ss * (1.f / QL) + EPS);
            const u32x4 zk = ((const u32x4*)(z + OFF_KV))[l16];
            kv[0] = bflo(zk.x); kv[1] = bfhi(zk.x); kv[2] = bflo(zk.y); kv[3] = bfhi(zk.y); kv[4] = bflo(zk.z); kv[5] = bfhi(zk.z); kv[6] = bflo(zk.w); kv[7] = bfhi(zk.w);
            const unsigned u1 = *(const unsigned*)(z + OFF_KR + axis * 32 + f), u2 = *(const unsigned*)(z + OFF_KR + axis * 32 + 16 + f);
            x1a = bflo(u1); x1b = bfhi(u1); x2a = bflo(u2); x2b = bfhi(u2);
        }
        float sk = 0.f;
#pragma unroll
        for (int i = 0; i < 8; ++i) sk += kv[i] * kv[i];
        sk += __shfl_xor(sk, 1); sk += __shfl_xor(sk, 2); sk += __shfl_xor(sk, 4); sk += __shfl_xor(sk, 8);
        const float rk = rsqrtf(sk * (1.f / KVL) + EPS);
        bf16_t* kl = KL + (size_t)key_index(r) * KW;
        const f32x4 g0 = ((const f32x4*)gkv)[2 * l16], g1 = ((const f32x4*)gkv)[2 * l16 + 1];
        u32x4 w; w.x = cvt_pk_bf16(kv[0] * rk * g0.x, kv[1] * rk * g0.y); w.y = cvt_pk_bf16(kv[2] * rk * g0.z, kv[3] * rk * g0.w); w.z = cvt_pk_bf16(kv[4] * rk * g1.x, kv[5] * rk * g1.y); w.w = cvt_pk_bf16(kv[6] * rk * g1.z, kv[7] * rk * g1.w);
        ((u32x4*)kl)[l16] = w;
        if (r >= NCTX) { const int tpos = (r - NCTX) & (SEQ - 1); const f32x2* tb = tab + (axis ? (tpos & 63) : (tpos >> 6)) * 16 + f; const f32x2 ca = tb[0], cb = tb[1];
            float a_, b_; a_ = x1a; b_ = x2a; x1a = a_ * ca.x - b_ * ca.y; x2a = a_ * ca.y + b_ * ca.x; a_ = x1b; b_ = x2b; x1b = a_ * cb.x - b_ * cb.y; x2b = a_ * cb.y + b_ * cb.x; }
        u32x2 wr_; wr_.x = cvt_pk_bf16(x1a, x2a); wr_.y = cvt_pk_bf16(x1b, x2b);
        ((u32x2*)(kl + 128))[l16] = wr_;
    }
#if POOL2
    const int c = (C.tid & 255) * 2, gsel = c >> 7;
    for (int s2 = (l > 0 ? NCTX / 32 : 0) + C.bid; s2 < MROWS / 32; s2 += C.G) {
        const int r0 = (2 * s2 + (C.tid >> 8)) * 16; int seq_lo, seq_hi;
        if (r0 < NCTX) { seq_lo = (r0 / CTX) * CTX; seq_hi = seq_lo + CTX; } else { seq_lo = NCTX + ((r0 - NCTX) / SEQ) * SEQ; seq_hi = seq_lo + SEQ; }
        if (gsel == 0) pool_strip2<1>(ZA, D, r0, seq_lo, seq_hi, c);
        else if (gsel == 1) pool_strip2<2>(ZA, D, r0, seq_lo, seq_hi, c);
        else if (gsel == 2) pool_strip2<4>(ZA, D, r0, seq_lo, seq_hi, c);
        else pool_strip2<8>(ZA, D, r0, seq_lo, seq_hi, c);
    }
#else
    const int c = C.tid, gsel = c >> 7;
    for (int s = (l > 0 ? NCTX / 16 : 0) + C.bid; s < MROWS / 16; s += C.G) {
        const int r0 = s * 16; int seq_lo, seq_hi;
        if (r0 < NCTX) { seq_lo = (r0 / CTX) * CTX; seq_hi = seq_lo + CTX; } else { seq_lo = NCTX + ((r0 - NCTX) / SEQ) * SEQ; seq_hi = seq_lo + SEQ; }
        if (gsel == 0) pool_strip<1>(ZA, D, r0, seq_lo, seq_hi, c);
        else if (gsel == 1) pool_strip<2>(ZA, D, r0, seq_lo, seq_hi, c);
        else if (gsel == 2) pool_strip<4>(ZA, D, r0, seq_lo, seq_hi, c);
        else pool_strip<8>(ZA, D, r0, seq_lo, seq_hi, c);
    }
#endif
}

template <int ABL = 0> __device__ __forceinline__ void attn_phase(const Ctx& C, unsigned char* lds, int l) {
    const bf16_t* Q = (const bf16_t*)(C.ws + AR_Q); const bf16_t* KL = (const bf16_t*)(C.ws + AR_KL); bf16_t* O = (bf16_t*)(C.ws + AR_O);
    const float* rstdq = (const float*)(C.ws + WS_RSTDQ); const f32x2* tab = (const f32x2*)(C.ws + WS_TAB);
    const int nlat = NB * NH * (SEQ / 256), nctx = (l == 0) ? NB * NH : 0;
    for (int uid = C.bid; uid < nlat; uid += C.G) { const int b = uid / (NH * 16), h = (uid / 16) % NH, qt = uid % 16;
#if USE_MFMA_ATTN
        if (USE_ATTN2) { if (ATTN2_GSEL == 0 ? C.wave < 4 : ATTN2_GSEL == 1 ? (C.wave & 1) == 0 : (C.wave & 2) == 0) attn2::unit<true, ABL>((char*)lds, Q, KL + (size_t)b * KPB * KW, O, rstdq, tab, NCTX + b * SEQ + qt * 256, h, KPB); else attn2::unit<false, ABL>((char*)lds, Q, KL + (size_t)b * KPB * KW, O, rstdq, tab, NCTX + b * SEQ + qt * 256, h, KPB); }
        else attn::unit<ABL>((char*)lds, Q, KL + (size_t)b * KPB * KW, O, rstdq, tab, NCTX + b * SEQ + qt * 256, h, KPB);
#else
        attn_simple_unit(lds, Q, KL, O, rstdq, tab, NCTX + b * SEQ + qt * 256, h, b * KPB, KPB);
#endif
    }
    for (int v = C.G - 1 - C.bid; v < nctx; v += C.G) { const int b = v / NH, h = v % NH;
#if USE_MFMA_ATTN
        if (USE_ATTN2) { if (ATTN2_GSEL == 0 ? C.wave < 4 : ATTN2_GSEL == 1 ? (C.wave & 1) == 0 : (C.wave & 2) == 0) attn2::unit<true, ABL>((char*)lds, Q, KL + (size_t)b * KPB * KW, O, rstdq, tab, b * CTX, h, CTX); else attn2::unit<false, ABL>((char*)lds, Q, KL + (size_t)b * KPB * KW, O, rstdq, tab, b * CTX, h, CTX); }
        else attn::unit<ABL>((char*)lds, Q, KL + (size_t)b * KPB * KW, O, rstdq, tab, b * CTX, h, CTX);
#else
        attn_simple_unit(lds, Q, KL, O, rstdq, tab, b * CTX, h, b * KPB, CTX);
#endif
    }
}

#define GAS __attribute__((address_space(1)))
#define LAS __attribute__((address_space(3)))
#define XB_TMO      128
#define XB_XCNT(j)  (256  + 64 * (j))
#define XB_XSUB(j)  (1280 + 64 * (j))
#define XB_XGEN(j)  (2304 + 64 * (j))
#define XB_TOP      3328
#define XB_TOPGEN   3392
#define XCD_BAR_WORDS 3456
#define XB_SPIN_CAP (1u << 18)

__device__ __forceinline__ unsigned xb_ld(unsigned* p)              { return __hip_atomic_load(p, __ATOMIC_RELAXED, __HIP_MEMORY_SCOPE_AGENT); }
__device__ __forceinline__ unsigned xb_add(unsigned* p, unsigned v) { return __hip_atomic_fetch_add(p, v, __ATOMIC_RELAXED, __HIP_MEMORY_SCOPE_AGENT); }
__device__ __forceinline__ unsigned xb_xcc_id() { return (unsigned)__builtin_amdgcn_s_getreg((3 << 11) | 20) & 0xFu; }
#define XB_SPIN(cond, bar) do { unsigned _sp = 0; while (cond) { __builtin_amdgcn_s_sleep(1); \
    if ((++_sp & 255u) == 0u) { if (xb_ld(&(bar)[XB_TMO])) break; if (_sp > XB_SPIN_CAP) { atomicAdd(&(bar)[XB_TMO], 1u); break; } } } } while (0)

struct XcdBarrier {
    unsigned* bar; unsigned x;
    volatile LAS unsigned* st;
};

__device__ __forceinline__ XcdBarrier xcd_barrier_post(unsigned* bar, volatile LAS unsigned* st) {
    XcdBarrier b; b.bar = bar; b.x = xb_xcc_id(); b.st = st;
    if (threadIdx.x == 0) (void)xb_add(&bar[XB_XCNT(b.x)], 1u);
    return b;
}
__device__ __forceinline__ void xcd_barrier_complete(unsigned* bar, unsigned x, unsigned& nloc, unsigned& nx) {
    const unsigned G = gridDim.x * gridDim.y * gridDim.z;
    unsigned sum, cnt, mine, sp = 0u;
    for (;;) {
        sum = 0u; cnt = 0u; mine = 0u;
#pragma unroll
        for (unsigned j = 0; j < 16; ++j) { const unsigned c = xb_ld(&bar[XB_XCNT(j)]); sum += c; cnt += (c > 0u) ? 1u : 0u; mine = (j == x) ? c : mine; }
        if (sum == G) break;
        __builtin_amdgcn_s_sleep(1);
        if ((++sp & 255u) == 0u) { if (xb_ld(&bar[XB_TMO])) break; if (sp > XB_SPIN_CAP) { atomicAdd(&bar[XB_TMO], 1u); break; } }
    }
    nloc = mine > 0u ? mine : 1u; nx = cnt > 0u ? cnt : 1u;
}

__device__ __forceinline__ void xcd_barrier(const XcdBarrier& b) {
    asm volatile("s_waitcnt vmcnt(0)" ::: "memory");
    __syncthreads();
    if (threadIdx.x == 0) {
        unsigned* bar = b.bar;
        __builtin_amdgcn_s_waitcnt(0);
        unsigned nloc = b.st[0], nx = b.st[1];
        if (nloc == 0u) { xcd_barrier_complete(bar, b.x, nloc, nx); b.st[0] = nloc; b.st[1] = nx; }
        const unsigned old = xb_add(&bar[XB_XSUB(b.x)], 1u);
        const unsigned gen = old / nloc;
        if (old + 1u == (gen + 1u) * nloc) {
            __builtin_amdgcn_fence(__ATOMIC_RELEASE, "agent");
            asm volatile("s_waitcnt vmcnt(0)" ::: "memory");
            const unsigned og = xb_add(&bar[XB_TOP], 1u);
            const unsigned tg = og / nx;
            if (og + 1u == (tg + 1u) * nx) xb_add(&bar[XB_TOPGEN], 1u);
            else XB_SPIN(xb_ld(&bar[XB_TOPGEN]) == tg, bar);
            __builtin_amdgcn_fence(__ATOMIC_ACQUIRE, "agent");
            xb_add(&bar[XB_XGEN(b.x)], 1u);
            asm volatile("s_waitcnt vmcnt(0)" ::: "memory");
        } else {
            XB_SPIN(xb_ld(&bar[XB_XGEN(b.x)]) == gen, bar);
            __builtin_amdgcn_fence(__ATOMIC_ACQUIRE, "agent");
            asm volatile("s_waitcnt vmcnt(0)" ::: "memory");
        }
    }
    __syncthreads();
}

#define RUN(k) (ph_lo <= (k) && (k) < ph_hi)
#define SEAM() do { if (RUN(phase) && RUN(phase + 1)) { if (USE_CG_FIRST == 1 && phase == 0) grid.sync(); else xcd_barrier(bar); } ++phase; asm volatile("" : "+s"(C.ws), "+s"(C.out), "+s"(C.bid), "+s"(C.G)); ws = C.ws; } while (0)
#define MOD ((float*)(ws + WS_MOD))
#define W ((const bf16_t*)(ws + WS_W + (size_t)l * LW_BYTES))
#define modl (MOD + (size_t)l * 5 * NMOD * DM)
template <int l>
__device__ __forceinline__ void run_layer(Ctx& C, unsigned char* lds, cg::grid_group& grid, const XcdBarrier& bar, int& phase, const int ph_lo, const int ph_hi) {
    gws_t ws = C.ws;
        const bool last = (l == DEPTH - 1);
        constexpr int TM0 = (l == 0) ? 0 : NCTX / BM, TMN = MROWS / BM - TM0;
        constexpr int ROW0 = TM0 * BM;
        if (RUN(phase)) {
            { Gemm<DM, DM, DM> g{(const bf16_t*)(ws + AR_H), W + W_IN}; StaticOrder S; S.init(TMN, NIN / BM, C.G, C.bid, TM0);
              EpiZ E{(bf16_t*)(ws + AR_ZA), (bf16_t*)(ws + AR_G0), (bf16_t*)(ws + AR_G1)}; if (GEMM_ON(0)) gemm_phase_any(lds, g, S, E); if (DUP(3)) gemm_phase_any(lds, g, S, E); }
#if P0_LAZY
            if (l == 0) {
              constexpr int NZ4 = (MROWS / BM) * (NIN / BM) - 3 * 256;
              if (C.G == 256 && C.bid >= NZ4) { p0_folds(C, lds, 0, C.bid - NZ4, C.G - NZ4); p0_transposes(C, lds, 0, C.bid - NZ4, C.G - NZ4, TR_R0); }
              else if (C.G != 256) { p0_folds(C, lds, 0, C.bid, C.G); p0_transposes(C, lds, 0, C.bid, C.G, TR_R0); } }
#endif
            if (l > 0) {
              Gemm<DM, DM, 256> g{(const bf16_t*)(ws + AR_H), W + W_IN}; SplitOrder S; S.init(NCTX / BM, 1, 4, 256, C.G, (C.bid + 128) % C.G, 0, 1);
              EpiSlab<256, NCTX, true> E{(void*)(ws + WS_SLZ), 256}; gemm_phase_any(lds, g, S, E); }
        }
        SEAM();
        if (RUN(phase)) {
            { Gemm<ZAW, QL, QL> g{(const bf16_t*)(ws + AR_ZA), W + W_Q}; StaticOrder S; S.init(TMN, QW / BM, C.G, C.bid, TM0);
              EpiN<0, QW> E{(bf16_t*)(ws + AR_Q), nullptr, nullptr}; if (GEMM_ON(1)) gemm_phase_any(lds, g, S, E); }
            p3a_rowops(C, l); if (DUP(2)) p3a_rowops(C, l);
        }
        SEAM();
        if (RUN(phase)) {
            { Gemm<PW, PW, PW> g{(const bf16_t*)(ws + AR_D), W + W_PC}; StaticOrder S; S.init(TMN, DM / BM, C.G, C.bid, TM0);
              EpiN<1> E{(bf16_t*)(ws + AR_G1), nullptr, nullptr}; if (GEMM_ON(2)) gemm_phase_any(lds, g, S, E); }
            if (DUP(1)) attn_phase<ATTN_ABL>(C, lds, l); attn_phase(C, lds, l);
#if HOST_ATTN
            if (l == 0 && DEPTH > 1 && C.G == 256 && C.bid >= 16 && C.bid < 224) { __syncthreads(); p0_transposes(C, lds, 1, C.bid - 16, 208, 0, HOST_ATTN); }
#endif
        }
        SEAM();
        if (RUN(phase)) { Gemm<DM, DM, DM> g{(const bf16_t*)(ws + AR_O), W + W_O}; StaticOrder S; S.init(TMN, DM / BM, C.G, C.bid, TM0);
            EpiN<2> E{(bf16_t*)(ws + AR_MG), (const bf16_t*)(ws + AR_G0), (const bf16_t*)(ws + AR_G1)}; if (GEMM_ON(3)) gemm_phase_any(lds, g, S, E); if (DUP(6)) gemm_phase_any(lds, g, S, E);
            if (l == 0 && DEPTH > 1 && C.bid >= LZY0) p0_transposes(C, lds, 1, C.bid - LZY0, C.G - LZY0, (HOST_ATTN && C.G == 256) ? HOST_ATTN : 0); }
        SEAM();
        if (RUN(phase)) { Gemm<DM, DM, DM> g{(const bf16_t*)(ws + AR_MG), W + W_OUT}; StaticOrder S; S.init(TMN, DM / BM, C.G, C.bid, TM0);
            EpiN<0> E{(bf16_t*)(ws + AR_Y), nullptr, nullptr}; if (GEMM_ON(4)) gemm_phase_any(lds, g, S, E);
            if (l == 0 && DEPTH > 1 && C.bid >= LZY0) p0_folds(C, lds, 1, C.bid - LZY0, C.G - LZY0); }
        SEAM();
        if (RUN(phase)) row_pass(C, ROW0, MROWS, l == 0, (const bf16_t*)(ws + AR_Y), C.in(17) + l * DM, 2, (bf16_t*)(ws + AR_HF), C.in(18) + l * DM, modl, modl, 3, 4);
        SEAM();
        if (RUN(phase)) { Gemm<DM, DM, DM> g{(const bf16_t*)(ws + AR_HF), W + W_GU}; StaticOrder S; S.init(TMN, NGU / BM, C.G, C.bid, TM0);
            EpiGU E{(bf16_t*)(ws + AR_ACT)}; if (GEMM_ON(5)) gemm_phase_any(lds, g, S, E); if (DUP(4)) gemm_phase_any(lds, g, S, E); }
        SEAM();
        if (RUN(phase)) {
            { Gemm<DFF, DFF, DFF> g{(const bf16_t*)(ws + AR_ACT), W + W_DN}; StaticOrder S; S.init(MROWS / BM - NCTX / BM, DM / BM, C.G, C.bid, NCTX / BM);
              EpiN<0> E{(bf16_t*)(ws + AR_F), nullptr, nullptr}; if (GEMM_ON(6)) gemm_phase_any(lds, g, S, E); if (DUP(5)) gemm_phase_any(lds, g, S, E); }
            if (l == 0) {
              Gemm<DFF, DFF, 256> g{(const bf16_t*)(ws + AR_ACT), W + W_DN}; SplitOrder S; S.init(NCTX / BM, DM / BM, NSD, 256, C.G, C.bid, 0, 0);
              EpiSlab<DM, NCTX, false> E{(void*)(ws + AR_SLD), 0}; gemm_phase_any(lds, g, S, E); }
        }
        SEAM();
        if (RUN(phase)) row_pass(C, ROW0, MROWS, false, (const bf16_t*)(ws + AR_F), C.in(22) + l * DM, 5, last ? nullptr : (bf16_t*)(ws + AR_H),
                                 last ? nullptr : C.in(6) + (l + 1) * DM, modl, last ? nullptr : modl + 5 * NMOD * DM, 0, 1, l == 0 ? (const bf16_t*)(ws + AR_SLD) : nullptr);
        if (!last) SEAM();
}

__global__ void __launch_bounds__(NTHREADS, 2) mega_fwd(Args a) {
    extern __shared__ __attribute__((aligned(16))) unsigned char lds[];
    cg::grid_group grid = cg::this_grid();
    const int tid_ = threadIdx.x;
    Ctx C{(gout_t)a.out, (gws_t)a.ws, tid_, tid_ & 63, __builtin_amdgcn_readfirstlane(tid_ >> 6), (int)gridDim.x, (int)blockIdx.x};
    gws_t ws = C.ws;
    int phase = 0;
    const int ph_lo = a.ph_lo, ph_hi = a.ph_hi;
    if (USE_CG_FIRST == 2 && ph_lo > ph_hi) grid.sync();
    volatile LAS unsigned* bst = (volatile LAS unsigned*)((LAS unsigned char*)lds + LDS_BYTES - 64);
    if (tid_ < 2) bst[tid_] = 0u;
    __syncthreads();
    const XcdBarrier bar = xcd_barrier_post((unsigned*)(C.ws + WS_CTL) + 4096, bst);

#ifndef DIS_P0
#if P0_LAZY
    if (RUN(phase)) { p0_transposes(C, lds, 0, C.bid, C.G, 0, TR_R0); p0_mod_tab(C, lds); }
#else
    if (RUN(phase)) { p0_transposes(C, lds, 0, C.bid, C.G); p0_folds(C, lds, 0, C.bid, C.G); p0_mod_tab(C, lds); }
#endif
#endif
    SEAM();
    if (RUN(phase)) { row_pass(C, 0, MROWS, true, nullptr, nullptr, 0, (bf16_t*)(ws + AR_H), C.in(6), nullptr, MOD, 0, 1); if (DUP(7)) row_pass(C, 0, MROWS, true, nullptr, nullptr, 0, (bf16_t*)(ws + AR_H), C.in(6), nullptr, MOD, 0, 1); }
    SEAM();
    run_layer<0>(C, lds, grid, bar, phase, ph_lo, ph_hi);
    run_layer<1>(C, lds, grid, bar, phase, ph_lo, ph_hi);
}

constexpr int N_PHASES = 2 + 9 * DEPTH;

extern "C" void kernel_launch(void* const* d_in, const int* in_sizes, int n_in, void* d_out, int out_size, void* d_ws, size_t ws_size, hipStream_t stream) {
    static int grid = 0;
    if (grid == 0) {
        if (n_in != 23 || out_size != NB * SEQ * DM || ws_size < WS_END) { fprintf(stderr, "kernel_launch: unexpected shapes (n_in %d out %d ws %zu need %zu)\n", n_in, out_size, ws_size, (size_t)WS_END); grid = -1; return; }
        int dev = 0, cus = 0, per_cu = 0;
        (void)hipGetDevice(&dev); (void)hipDeviceGetAttribute(&cus, hipDeviceAttributeMultiprocessorCount, dev);
        if (hipFuncSetAttribute((const void*)mega_fwd, hipFuncAttributeMaxDynamicSharedMemorySize, LDS_BYTES) != hipSuccess) { fprintf(stderr, "kernel_launch: hipFuncSetAttribute failed\n"); grid = -1; return; }
        if (hipOccupancyMaxActiveBlocksPerMultiprocessor(&per_cu, (const void*)mega_fwd, NTHREADS, LDS_BYTES) != hipSuccess || per_cu < 1) { fprintf(stderr, "kernel_launch: occupancy query says %d\n", per_cu); per_cu = 1; }
        (void)hipGetLastError();
        grid = cus;
        fprintf(stderr, "kernel_launch: grid %d (cus %d, per_cu %d), ws %zu\n", grid, cus, per_cu, ws_size);
    }
    if (grid < 0) return;
    (void)hipMemsetAsync((char*)d_ws + WS_CTL, 0, 64 * 1024, stream);
    Args a{};
    for (int i = 0; i < 23; ++i) a.in[i] = (const float*)d_in[i];
    a.out = (float*)d_out; a.ws = (unsigned char*)d_ws; a.ph_lo = 0; a.ph_hi = N_PHASES;
    void* args[] = {&a};
    hipError_t e = hipLaunchCooperativeKernel((const void*)mega_fwd, dim3(grid), dim3(NTHREADS), args, LDS_BYTES, stream);
    if (e != hipSuccess) fprintf(stderr, "kernel_launch: cooperative launch failed: %s (grid %d)\n", hipGetErrorString(e), grid);
}
```
